# Optimizing an MI355X kernel written in HIP

```python
import math
import jax, jax.numpy as jnp
from jax import lax
import numpy as np

D_MODEL = 4096
BATCH = 8
SEQ = 2048
DEPTH = 2
DEC_BATCH = 2
DEC_SEQ = 8192
PAST_LEN = 128

N_META = 16
N_MIXERS = 2
RET_HEADS = 16
RET_DK = D_MODEL // RET_HEADS
RET_DV = 2 * RET_DK
RET_QK = RET_HEADS * RET_DK
RET_V = RET_HEADS * RET_DV
RET_CHUNK = 128
RET_THETA = 10000.0
DIFF_HEADS = 32
DIFF_DH = 128
DIFF_DV = 2 * DIFF_DH
DIFF_QK = DIFF_HEADS * 2 * DIFF_DH
DIFF_V = DIFF_HEADS * DIFF_DV
DIFF_ROT = DIFF_DH // 4
ROPE_THETA = 500000.0
Q_BLOCK = 128
N_RET = (DEPTH + 1) // 2
N_DIFF = DEPTH // 2
NORM_EPS = 1e-6

kernel_name = 'hybrid_retention_diffattn_encoder'


def rms_norm(x, gain=None, eps=NORM_EPS):
    xf = x.astype(jnp.float32)
    y = xf * lax.rsqrt(jnp.mean(xf * xf, axis=-1, keepdims=True) + eps)
    if gain is not None:
        y = y * gain.astype(jnp.float32)
    return y.astype(x.dtype)


def rotary(x, pos, rot_dim, theta):
    half = rot_dim // 2
    inv_freq = jnp.power(jnp.float32(theta), -jnp.arange(half, dtype=jnp.float32) * 2.0 / rot_dim)
    ang = pos[:, None] * inv_freq[None, :]
    shape = (pos.shape[0],) + (1,) * (x.ndim - 3) + (half,)
    cos = jnp.cos(ang).reshape(shape)
    sin = jnp.sin(ang).reshape(shape)
    xf = x.astype(jnp.float32)
    x1 = xf[..., :half]
    x2 = xf[..., half:rot_dim]
    out = jnp.concatenate([x1 * cos - x2 * sin, x2 * cos + x1 * sin, xf[..., rot_dim:]], axis=-1)
    return out.astype(x.dtype)


def retention_chunkwise(q, k, v, log_gamma, include_diag):
    B, Lp, H, dk = q.shape
    dv = v.shape[-1]
    C = RET_CHUNK
    N = Lp // C
    qc = q.reshape(B, N, C, H, dk)
    kc = k.reshape(B, N, C, H, dk)
    vc = v.reshape(B, N, C, H, dv)
    idx = jnp.arange(C, dtype=jnp.float32)
    rel = idx[:, None] - idx[None, :]
    mask = (rel >= 0) if include_diag else (rel > 0)
    decay = jnp.where(mask[None], jnp.exp(jnp.where(mask, rel, 0.0)[None] * log_gamma[:, None, None]), 0.0)
    scores = jnp.einsum('bnihd,bnjhd->bnhij', qc, kc) * decay[None, None]
    intra = jnp.einsum('bnhij,bnjhe->bnihe', scores, vc)
    q_decay = jnp.exp((idx + 1.0)[:, None] * log_gamma[None, :])
    k_decay = jnp.exp((C - 1.0 - idx)[:, None] * log_gamma[None, :])
    chunk_decay = jnp.exp(C * log_gamma)

    def step(state, inp):
        qn, kn, vn = inp
        cross = jnp.einsum('bihd,bhde->bihe', qn * q_decay[None, :, :, None], state)
        state = state * chunk_decay[None, :, None, None] + jnp.einsum(
            'bjhd,bjhe->bhde', kn * k_decay[None, :, :, None], vn)
        return state, cross

    init = jnp.zeros((B, H, dk, dv), jnp.float32)
    _, cross = lax.scan(step, init, (jnp.moveaxis(qc, 1, 0), jnp.moveaxis(kc, 1, 0), jnp.moveaxis(vc, 1, 0)))
    out = intra + jnp.moveaxis(cross, 0, 1)
    return out.reshape(B, Lp, H, dv)


def retention_mixer(h, w_in, w_out, decay_fwd_raw, decay_bwd_raw):
    B, L, _ = h.shape
    proj = h @ w_in
    q, k, v, g = jnp.split(proj, [RET_QK, 2 * RET_QK, 2 * RET_QK + RET_V], axis=-1)
    q = q.reshape(B, L, RET_HEADS, RET_DK)
    k = k.reshape(B, L, RET_HEADS, RET_DK)
    v = v.reshape(B, L, RET_HEADS, RET_DV)
    pos = jnp.arange(L, dtype=jnp.float32)
    q = rotary(q, pos, RET_DK, RET_THETA).astype(jnp.float32) * (RET_DK ** -0.5)
    k = rotary(k, pos, RET_DK, RET_THETA).astype(jnp.float32)
    pad = RET_CHUNK - N_META
    padt = lambda t: jnp.pad(t.astype(jnp.float32), ((0, 0), (pad, 0), (0, 0), (0, 0)))
    qp, kp, vp = padt(q), padt(k), padt(v)
    lg_f = -jnp.exp(decay_fwd_raw.astype(jnp.float32))
    lg_b = -jnp.exp(decay_bwd_raw.astype(jnp.float32))
    fwd = retention_chunkwise(qp, kp, vp, lg_f, True)
    flip = lambda t: jnp.flip(t, axis=1)
    bwd = flip(retention_chunkwise(flip(qp), flip(kp), flip(vp), lg_b, False))
    o = (fwd + bwd)[:, pad:]
    o = rms_norm(o)
    o = o.reshape(B, L, RET_V).astype(h.dtype) * jax.nn.silu(g)
    return o @ w_out


def diff_attn_mixer(h, w_in, w_out, lq1, lk1, lq2, lk2, subln, lambda_init):
    B, L, _ = h.shape
    proj = h @ w_in
    q, k, v, g = jnp.split(proj, [DIFF_QK, 2 * DIFF_QK, 2 * DIFF_QK + DIFF_V], axis=-1)
    q = q.reshape(B, L, DIFF_HEADS, 2, DIFF_DH)
    k = k.reshape(B, L, DIFF_HEADS, 2, DIFF_DH)
    v = v.reshape(B, L, DIFF_HEADS, DIFF_DV)
    pos = jnp.arange(L, dtype=jnp.float32)
    q = rotary(q, pos, DIFF_ROT, ROPE_THETA)
    k = rotary(k, pos, DIFF_ROT, ROPE_THETA)
    lam = (jnp.exp(jnp.sum(lq1.astype(jnp.float32) * lk1.astype(jnp.float32)))
           - jnp.exp(jnp.sum(lq2.astype(jnp.float32) * lk2.astype(jnp.float32))) + lambda_init)
    nb = -(-L // Q_BLOCK)
    Lq = nb * Q_BLOCK
    qb = jnp.pad(q, ((0, 0), (0, Lq - L), (0, 0), (0, 0), (0, 0))).reshape(B, nb, Q_BLOCK, DIFF_HEADS, 2, DIFF_DH)
    qb = jnp.moveaxis(qb, 1, 0)
    scale = DIFF_DH ** -0.5

    def block(qi):
        s = jnp.einsum('bqhmd,bkhmd->bhmqk', qi, k).astype(jnp.float32) * scale
        p = jax.nn.softmax(s, axis=-1)
        a = p[:, :, 0] - lam * p[:, :, 1]
        return jnp.einsum('bhqk,bkhe->bqhe', a.astype(v.dtype), v)

    o = lax.map(block, qb)
    o = jnp.moveaxis(o, 0, 1).reshape(B, Lq, DIFF_HEADS, DIFF_DV)[:, :L]
    o = rms_norm(o, subln, eps=1e-5) * (1.0 - lambda_init)
    o = o.reshape(B, L, DIFF_V) * jax.nn.silu(g)
    return o @ w_out


def setup_inputs(seed: int = 0) -> dict:
    key = jax.random.key(seed)
    ks = jax.random.split(key, 16)
    f32 = jnp.float32
    ret_in = 2 * RET_QK + 2 * RET_V
    diff_in = 2 * DIFF_QK + 2 * DIFF_V
    base = (-5.0 - jnp.arange(RET_HEADS, dtype=f32)) * math.log(2.0)
    return {
        'x_prompt': jax.random.normal(ks[0], (BATCH, SEQ, D_MODEL), f32),
        'x_sample': jax.random.normal(ks[1], (DEC_BATCH, DEC_SEQ, D_MODEL), f32),
        'meta_tokens': jax.random.normal(ks[2], (N_META, D_MODEL), f32),
        'pre_norm': 1.0 + 0.02 * jax.random.normal(ks[3], (DEPTH, D_MODEL), f32),
        'post_norm': 1.0 + 0.02 * jax.random.normal(ks[4], (DEPTH, D_MODEL), f32),
        'ret_w_in': jax.random.normal(ks[5], (N_RET, D_MODEL, ret_in), f32) * D_MODEL ** -0.5,
        'ret_w_out': jax.random.normal(ks[6], (N_RET, RET_V, D_MODEL), f32) * RET_V ** -0.5,
        'ret_decay_fwd': base[None, :] + 0.05 * jax.random.normal(ks[7], (N_RET, RET_HEADS), f32),
        'ret_decay_bwd': base[None, :] + 0.05 * jax.random.normal(ks[8], (N_RET, RET_HEADS), f32),
        'diff_w_in': jax.random.normal(ks[9], (N_DIFF, D_MODEL, diff_in), f32) * D_MODEL ** -0.5,
        'diff_w_out': jax.random.normal(ks[10], (N_DIFF, DIFF_V, D_MODEL), f32) * DIFF_V ** -0.5,
        'diff_lambda_q1': 0.1 * jax.random.normal(ks[11], (N_DIFF, DIFF_DH), f32),
        'diff_lambda_k1': 0.1 * jax.random.normal(ks[12], (N_DIFF, DIFF_DH), f32),
        'diff_lambda_q2': 0.1 * jax.random.normal(ks[13], (N_DIFF, DIFF_DH), f32),
        'diff_lambda_k2': 0.1 * jax.random.normal(ks[14], (N_DIFF, DIFF_DH), f32),
        'diff_subln': 1.0 + 0.02 * jax.random.normal(ks[15], (N_DIFF, DIFF_DV), f32),
    }


def reference(x_prompt, x_sample, meta_tokens, pre_norm, post_norm, ret_w_in, ret_w_out,
              ret_decay_fwd, ret_decay_bwd, diff_w_in, diff_w_out, diff_lambda_q1,
              diff_lambda_k1, diff_lambda_q2, diff_lambda_k2, diff_subln):
    def trunk(x):
        B = x.shape[0]
        meta = jnp.broadcast_to(meta_tokens.astype(x.dtype)[None], (B, N_META, D_MODEL))
        x = jnp.concatenate([meta, x], axis=1)
        for i in range(DEPTH):
            h = rms_norm(x, pre_norm[i])
            j = i // N_MIXERS
            if i % N_MIXERS == 0:
                m = retention_mixer(h, ret_w_in[j], ret_w_out[j], ret_decay_fwd[j], ret_decay_bwd[j])
            else:
                lambda_init = 0.8 - 0.6 * math.exp(-0.3 * i)
                m = diff_attn_mixer(h, diff_w_in[j], diff_w_out[j], diff_lambda_q1[j], diff_lambda_k1[j],
                                    diff_lambda_q2[j], diff_lambda_k2[j], diff_subln[j], lambda_init)
            x = x + rms_norm(m, post_norm[i])
        return x[:, N_META:]

    y_prompt = trunk(x_prompt)
    y_sample = trunk(x_sample)
    return (y_prompt, y_sample)
```

```cpp
#include <hip/hip_runtime.h>
#include <cstdio>
#include <cstdint>

#define LAS __attribute__((address_space(3)))
typedef unsigned short bf16_t;
typedef short bf16x8 __attribute__((ext_vector_type(8)));
typedef short s16x4 __attribute__((ext_vector_type(4)));
typedef float f32x4 __attribute__((ext_vector_type(4)));
typedef float f32x2 __attribute__((ext_vector_type(2)));
typedef float f32x16 __attribute__((ext_vector_type(16)));
typedef unsigned u32x4 __attribute__((ext_vector_type(4)));
typedef unsigned u32x2 __attribute__((ext_vector_type(2)));

__device__ __forceinline__ unsigned pkbf(float lo, float hi) {
    typedef __bf16 bf2 __attribute__((ext_vector_type(2)));
    bf2 r = __builtin_convertvector((f32x2){lo, hi}, bf2);
    return __builtin_bit_cast(unsigned, r);
}
__device__ __forceinline__ float bflo(unsigned w) { return __uint_as_float(w << 16); }
__device__ __forceinline__ float bfhi(unsigned w) { return __uint_as_float(w & 0xffff0000u); }
__device__ __forceinline__ float wave_sum(float v) {
#pragma unroll
    for (int o = 1; o < 64; o <<= 1) v += __shfl_xor(v, o);
    return v;
}
#define LDS_WAIT() asm volatile("s_waitcnt lgkmcnt(0)" ::: "memory")
#define VM_WAIT() asm volatile("s_waitcnt vmcnt(0)" ::: "memory")

namespace pg8 {
#define PG8_LAS __attribute__((address_space(3)))
constexpr int BM = 256, BK = 64, HALF = 128, HTB = HALF * BK * 2  , STAGE_BYTES = 8 * HTB, NXCD = 8, WGM = 4;

__host__ __device__ __forceinline__ int lds_byte(int r, int c) { const int st = (r >> 4) * 2 + (c >> 5), rr = r & 15, cc = c & 31, ob = rr * 64 + cc * 2; return st * 1024 + (ob ^ (((ob >> 9) & 1) << 5)); }
__host__ __device__ __forceinline__ void stage_rc(int b, int& R, int& C) { const int st = b / 1024, sb = b % 1024, swz = sb ^ (((sb >> 9) & 1) << 5); R = (st >> 1) * 16 + swz / 64; C = (st & 1) * 32 + (swz % 64) / 2; }
__host__ __device__ __forceinline__ int perm32(int rho) { const int n = rho >> 4, i = rho & 15; return 8 * (i >> 2) + 4 * n + (i & 3); }

struct Unit { int pm, pn, k0, nkt, atom; };
struct Gemm { const bf16_t* A; const bf16_t* Bt; int M, N, K; };

#ifndef PG8_COL_OUTER
#define PG8_COL_OUTER 1
#endif
struct StaticOrder {
    int nM, nN, nwg, G, c, kt, full, left, S;
    __host__ __device__ __forceinline__ void init(int M, int N, int K, int G_, int c_, int split) { nM = M / BM; nN = N / BM; nwg = nM * nN; G = G_; c = c_; kt = K / BK; full = nwg / G; left = nwg - full * G; S = 1;
        if (split && left > 0 && 2 * left <= G) { S = 2; while (2 * S * left <= G && (kt / (2 * S)) >= 4 && (kt % (2 * S)) == 0) S *= 2; } }
    __host__ __device__ __forceinline__ void tile_of(int L, Unit& u) const {
        int wgid = L; { const int q = nwg / NXCD, r = nwg % NXCD, xcd = wgid % NXCD, off = wgid / NXCD; wgid = (xcd < r ? xcd * (q + 1) : r * (q + 1) + (xcd - r) * q) + off; }
#if PG8_COL_OUTER
        constexpr int CGC = 8;
        const int ncg = CGC * nM, cg = wgid / ncg, fc = cg * CGC, csz = (nN - fc) < CGC ? (nN - fc) : CGC;
        const int r = wgid - cg * ncg, sup = WGM * csz, rg = r / sup, fm = rg * WGM, gsz = (nM - fm) < WGM ? (nM - fm) : WGM, w = r - rg * sup;
        u.pm = fm + (w % gsz); u.pn = fc + (w / gsz); }
#else
        const int nig = WGM * nN, gid = wgid / nig, fm = gid * WGM, gsz = (nM - fm) < WGM ? (nM - fm) : WGM;
        u.pm = fm + ((wgid % nig) % gsz); u.pn = (wgid % nig) / gsz; }
#endif
    __host__ __device__ __forceinline__ bool next(int i, Unit& u) const {
        const bool tailr = S > 1 && i == full;
        const int lu = tailr ? c / S : 0, ks = tailr ? c - lu * S : 0;
        const long L = tailr ? (long)full * G + lu : (long)i * G + c;
        if (tailr ? (c >= left * S) : (L >= nwg)) return false;
        const int nk = tailr ? kt / S : kt;
        tile_of((int)L, u); u.k0 = ks * nk; u.nkt = nk; u.atom = tailr ? 1 : 0; return true;
    }
    __host__ __device__ __forceinline__ int n_tail() const { return S > 1 ? left : 0; }
    __host__ __device__ __forceinline__ void tail_tile(int j, Unit& u) const { tile_of(full * G + j, u); }
    __device__ __forceinline__ void a_ready(const Unit&) const {}
    __device__ __forceinline__ void done(const Unit&) const {}
};

struct EpiM {
    static constexpr bool PERM = true, AFTER_DRAIN = false;
    bf16_t* C; int ldc; float* P;
    __device__ __forceinline__ void operator()(const f32x4 (&acc)[2][2][4][2], const Unit& u, int wr, int wc, int fr, int fq) const {
        if (!u.atom) {
            const int row0 = u.pm * BM + wr * 64 + fr, col0 = u.pn * BM + wc * 32 + 8 * fq;
#pragma unroll
            for (int ai = 0; ai < 2; ++ai)
#pragma unroll
                for (int m = 0; m < 4; ++m) { bf16_t* rowp = C + (size_t)(row0 + ai * HALF + m * 16) * ldc + col0;
#pragma unroll
                    for (int bj = 0; bj < 2; ++bj) { const f32x4 v0 = acc[ai][bj][m][0], v1 = acc[ai][bj][m][1];
                        u32x4 w; w.x = pkbf(v0[0], v0[1]); w.y = pkbf(v0[2], v0[3]); w.z = pkbf(v1[0], v1[1]); w.w = pkbf(v1[2], v1[3]);
                        *(u32x4*)(rowp + bj * HALF) = w; } }
        } else {
            int toff = (wr * 64 + fr) * 256 + wc * 32 + 8 * fq; asm volatile("" : "+v"(toff));
            float* T = P + (size_t)blockIdx.x * 65536 + toff;
#pragma unroll
            for (int ai = 0; ai < 2; ++ai)
#pragma unroll
                for (int m = 0; m < 4; ++m) { float* rowp = T + (ai * HALF + m * 16) * 256;
#pragma unroll
                    for (int bj = 0; bj < 2; ++bj) { *(f32x4*)(rowp + bj * HALF) = acc[ai][bj][m][0]; *(f32x4*)(rowp + bj * HALF + 4) = acc[ai][bj][m][1]; } }
        }
    }
};
struct EpiProj {
    static constexpr bool PERM = true, AFTER_DRAIN = false;
    bf16_t* baseA; size_t strideA; int ldA, shA, cA; bf16_t* baseB; size_t strideB; int ldB, shB;
    __device__ __forceinline__ void operator()(const f32x4 (&acc)[2][2][4][2], const Unit& u, int wr, int wc, int fr, int fq) const {
        const int row0 = u.pm * BM + wr * 64 + fr; const int colt = u.pn * BM;
        const bool inA = colt < cA; const int cc = inA ? colt : colt - cA; const int sh = inA ? shA : shB; const int t = cc >> sh;
        bf16_t* base = (inA ? baseA : baseB) + (size_t)t * (inA ? strideA : strideB);
        const int ldc = inA ? ldA : ldB;
        const int col0 = cc - (t << sh) + wc * 32 + 8 * fq;
#pragma unroll
        for (int ai = 0; ai < 2; ++ai)
#pragma unroll
            for (int m = 0; m < 4; ++m) { bf16_t* rowp = base + (size_t)(row0 + ai * HALF + m * 16) * ldc + col0;
#pragma unroll
                for (int bj = 0; bj < 2; ++bj) { const f32x4 v0 = acc[ai][bj][m][0], v1 = acc[ai][bj][m][1];
                    u32x4 w; w.x = pkbf(v0[0], v0[1]); w.y = pkbf(v0[2], v0[3]); w.z = pkbf(v1[0], v1[1]); w.w = pkbf(v1[2], v1[3]);
                    *(u32x4*)(rowp + bj * HALF) = w; } }
    }
};
template <int LAYER> struct EpiProjRope {
    static constexpr bool PERM = true, AFTER_DRAIN = false;
    EpiProj P; const bf16_t* ctab; const bf16_t* stab; int LP;
    __device__ __forceinline__ void operator()(const f32x4 (&acc)[2][2][4][2], const Unit& u, int wr, int wc, int fr, int fq) const {
        const int colt = u.pn * BM;
        const bool rot = LAYER == 0 ? (colt < 8192) : (colt < 16384 && wc == 0);
        if (!rot) { P(acc, u, wr, wc, fr, fq); return; }
        const int row0 = u.pm * BM + wr * 64 + fr;
        const int pos0 = row0 - (row0 / LP) * LP;
        if (LAYER == 0) {
            const int t = colt >> 12; bf16_t* base = P.baseA + (size_t)t * P.strideA; const float sc = t == 0 ? 0.0625f : 1.0f;
            const int d0 = wc * 32 + 8 * fq, col0 = colt - (t << 12) + d0;
            u32x4 cwa[8], swa[8];
#pragma unroll
            for (int ai = 0; ai < 2; ++ai)
#pragma unroll
                for (int m = 0; m < 4; ++m) { int pos = pos0 + ai * HALF + m * 16; pos = pos >= LP ? pos - LP : pos;
                    cwa[ai * 4 + m] = *(const u32x4*)(ctab + pos * 128 + d0); swa[ai * 4 + m] = *(const u32x4*)(stab + pos * 128 + d0); }
#pragma unroll
            for (int ai = 0; ai < 2; ++ai)
#pragma unroll
                for (int m = 0; m < 4; ++m) {
                    const u32x4 cw = cwa[ai * 4 + m], sw = swa[ai * 4 + m];
                    const f32x4 c0 = (f32x4){bflo(cw.x), bfhi(cw.x), bflo(cw.y), bfhi(cw.y)}, c1 = (f32x4){bflo(cw.z), bfhi(cw.z), bflo(cw.w), bfhi(cw.w)}, s0 = (f32x4){bflo(sw.x), bfhi(sw.x), bflo(sw.y), bfhi(sw.y)}, s1 = (f32x4){bflo(sw.z), bfhi(sw.z), bflo(sw.w), bfhi(sw.w)};
                    const f32x4 a0 = acc[ai][0][m][0], a1 = acc[ai][0][m][1], b0 = acc[ai][1][m][0], b1 = acc[ai][1][m][1];
                    const f32x4 x0 = (a0 * c0 - b0 * s0) * sc, x1 = (a1 * c1 - b1 * s1) * sc, y0 = (b0 * c0 + a0 * s0) * sc, y1 = (b1 * c1 + a1 * s1) * sc;
                    bf16_t* rowp = base + (size_t)(row0 + ai * HALF + m * 16) * 4096 + col0;
                    u32x4 w; w.x = pkbf(x0[0], x0[1]); w.y = pkbf(x0[2], x0[3]); w.z = pkbf(x1[0], x1[1]); w.w = pkbf(x1[2], x1[3]); *(u32x4*)rowp = w;
                    w.x = pkbf(y0[0], y0[1]); w.y = pkbf(y0[2], y0[3]); w.z = pkbf(y1[0], y1[1]); w.w = pkbf(y1[2], y1[3]); *(u32x4*)(rowp + HALF) = w;
                }
        } else {
            const int t = colt >> 13; bf16_t* base = P.baseB + (size_t)t * P.strideB;
            const int col0 = colt - (t << 13) + 8 * fq;
            const bool lo = fq < 2; const int i0 = 8 * (fq & 1);
            u32x4 cwa[8], swa[8];
#pragma unroll
            for (int ai = 0; ai < 2; ++ai)
#pragma unroll
                for (int m = 0; m < 4; ++m) { int pos = pos0 + ai * HALF + m * 16; pos = pos >= LP ? pos - LP : pos;
                    cwa[ai * 4 + m] = *(const u32x4*)(ctab + pos * 16 + i0); swa[ai * 4 + m] = *(const u32x4*)(stab + pos * 16 + i0); }
#pragma unroll
            for (int ai = 0; ai < 2; ++ai)
#pragma unroll
                for (int m = 0; m < 4; ++m) {
                    const u32x4 cw = cwa[ai * 4 + m], sw = swa[ai * 4 + m];
                    const f32x4 c0 = (f32x4){bflo(cw.x), bfhi(cw.x), bflo(cw.y), bfhi(cw.y)}, c1 = (f32x4){bflo(cw.z), bfhi(cw.z), bflo(cw.w), bfhi(cw.w)}, s0 = (f32x4){bflo(sw.x), bfhi(sw.x), bflo(sw.y), bfhi(sw.y)}, s1 = (f32x4){bflo(sw.z), bfhi(sw.z), bflo(sw.w), bfhi(sw.w)};
                    bf16_t* rowp = base + (size_t)(row0 + ai * HALF + m * 16) * 8192 + col0;
#pragma unroll
                    for (int bj = 0; bj < 2; ++bj) {
                        f32x4 v[2] = {acc[ai][bj][m][0], acc[ai][bj][m][1]}, o[2];
#pragma unroll
                        for (int n = 0; n < 2; ++n)
#pragma unroll
                            for (int j = 0; j < 4; ++j) {
                                const unsigned own = __float_as_uint(v[n][j]);
                                auto rr = __builtin_amdgcn_permlane32_swap(own, own, false, false);
                                const float pv = __uint_as_float(lo ? rr[1] : rr[0]);
                                const float c = n == 0 ? c0[j] : c1[j], s = n == 0 ? s0[j] : s1[j];
                                o[n][j] = lo ? v[n][j] * c - pv * s : v[n][j] * c + pv * s;
                            }
                        u32x4 w; w.x = pkbf(o[0][0], o[0][1]); w.y = pkbf(o[0][2], o[0][3]); w.z = pkbf(o[1][0], o[1][1]); w.w = pkbf(o[1][2], o[1][3]);
                        *(u32x4*)(rowp + bj * HALF) = w;
                    }
                }
        }
    }
};
template <class Epi, class Sched>
__device__ __forceinline__ void gemm_phase(PG8_LAS unsigned char* lds, const Gemm g, const Sched& S, const Epi& E, const int tid) {
    const int wid = __builtin_amdgcn_readfirstlane(tid >> 6), lane = tid & 63, wr = wid >> 2, wc = wid & 3, fr = lane & 15, fq = lane >> 4;
    const int K = g.K;
    unsigned voffA[2], voffB[2];
#pragma unroll
    for (int i = 0; i < 2; ++i) { int R, C; stage_rc(tid * 16 + i * 8192, R, C); const int Rb = Epi::PERM ? ((R & ~31) + perm32(R & 31)) : R;
        voffA[i] = (unsigned)(R * K + C) * 2u; voffB[i] = (unsigned)(Rb * K + C) * 2u; }
    const size_t kstep = (size_t)(BK * 2);
    const size_t hstep = (size_t)HALF * K * 2;
    const size_t tstep = 2 * hstep;
    const unsigned ldsw = (unsigned)wid * 1024u;
    const int aoff = lds_byte(wr * 64 + fr, fq * 8), boff = lds_byte(wc * 32 + fr, fq * 8);
#define PG8_SA(b, h) (((b) * 2 + (h)) * HTB)
#define PG8_SB(b, h) ((4 + (b) * 2 + (h)) * HTB)
#define PG8_STAGE(bufoff, gbase, voff) do { _Pragma("unroll") for (int _i = 0; _i < 2; ++_i) \
        __builtin_amdgcn_global_load_lds((const unsigned*)((const char*)(gbase) + (voff)[_i]), (PG8_LAS unsigned*)(lds + (bufoff) + ldsw + _i * 8192), 16, 0, 0); } while (0)
#define PG8_LDA(dst, b, h) do { _Pragma("unroll") for (int m = 0; m < 4; ++m) _Pragma("unroll") for (int k = 0; k < 2; ++k) dst[m][k] = *(const PG8_LAS bf16x8*)(lds + PG8_SA(b, h) + aoff + m * 2048 + k * 1024); } while (0)
#define PG8_LDB(dst, b, h) do { _Pragma("unroll") for (int n = 0; n < 2; ++n) _Pragma("unroll") for (int k = 0; k < 2; ++k) dst[n][k] = *(const PG8_LAS bf16x8*)(lds + PG8_SB(b, h) + boff + n * 2048 + k * 1024); } while (0)
#define PG8_MMA(ai, bj, At, Bt) do { __builtin_amdgcn_s_setprio(1); _Pragma("unroll") for (int m = 0; m < 4; ++m) _Pragma("unroll") for (int n = 0; n < 2; ++n) _Pragma("unroll") for (int k = 0; k < 2; ++k) \
        acc[ai][bj][m][n] = __builtin_amdgcn_mfma_f32_16x16x32_bf16(Bt[n][k], At[m][k], acc[ai][bj][m][n], 0, 0, 0); __builtin_amdgcn_s_setprio(0); } while (0)
#define PG8_WAIT_V(n) asm volatile("s_waitcnt vmcnt(" #n ")" ::: "memory")
#define PG8_WAIT_L(n) asm volatile("s_waitcnt lgkmcnt(" #n ")" ::: "memory")
#define PG8_BAR __builtin_amdgcn_s_barrier()
#define PG8_SCHED __builtin_amdgcn_sched_barrier(0)
    Unit cur, nxt; int ui = 0;
    if (!S.next(0, cur)) return;
    f32x4 acc[2][2][4][2];
#pragma unroll
    for (int a = 0; a < 2; ++a)
#pragma unroll
        for (int b = 0; b < 2; ++b)
#pragma unroll
            for (int m = 0; m < 4; ++m)
#pragma unroll
                for (int n = 0; n < 2; ++n) acc[a][b][m][n] = (f32x4){0.f, 0.f, 0.f, 0.f};
    bf16x8 At[4][2], B0[2][2], B1[2][2];
    const char* cA = (const char*)g.A + (size_t)cur.pm * tstep + (size_t)cur.k0 * kstep; const char* cB = (const char*)g.Bt + (size_t)cur.pn * tstep + (size_t)cur.k0 * kstep;
    S.a_ready(cur);
    PG8_STAGE(PG8_SB(0, 0), cB, voffB); PG8_STAGE(PG8_SA(0, 0), cA, voffA); PG8_STAGE(PG8_SB(0, 1), cB + hstep, voffB); PG8_STAGE(PG8_SA(0, 1), cA + hstep, voffA);
    if (wr == 1) PG8_BAR;
    PG8_WAIT_V(4); PG8_BAR;
    PG8_STAGE(PG8_SB(1, 0), cB + kstep, voffB); PG8_STAGE(PG8_SA(1, 0), cA + kstep, voffA); PG8_STAGE(PG8_SB(1, 1), cB + hstep + kstep, voffB);
    PG8_WAIT_V(6); PG8_BAR;
    for (;;) {
        const bool has_next = S.next(ui + 1, nxt);
        const char* nA = has_next ? (const char*)g.A + (size_t)nxt.pm * tstep + (size_t)nxt.k0 * kstep : cA; const char* nB = has_next ? (const char*)g.Bt + (size_t)nxt.pn * tstep + (size_t)nxt.k0 * kstep : cB;
        const int nt = cur.nkt;
        for (int t = 0; t < nt; t += 2) {
            const bool last = (t == nt - 2);
            const char* a1 = cA + (size_t)(t + 1) * kstep;
            const char* a2 = last ? nA : cA + (size_t)(t + 2) * kstep; const char* b2 = last ? nB : cB + (size_t)(t + 2) * kstep;
            const char* a3 = a2 + kstep; const char* b3 = b2 + kstep;
            if (last && has_next) S.a_ready(nxt);
            PG8_LDB(B0, 0, 0); PG8_SCHED; PG8_LDA(At, 0, 0); PG8_STAGE(PG8_SA(1, 1), a1 + hstep, voffA);
            PG8_WAIT_L(8); PG8_BAR; PG8_WAIT_L(0); PG8_MMA(0, 0, At, B0); PG8_BAR; PG8_SCHED;
            PG8_LDB(B1, 0, 1); PG8_STAGE(PG8_SB(0, 0), b2, voffB);
            PG8_BAR; PG8_WAIT_L(0); PG8_MMA(0, 1, At, B1); PG8_BAR;
            PG8_LDA(At, 0, 1); PG8_STAGE(PG8_SA(0, 0), a2, voffA);
            PG8_BAR; PG8_WAIT_L(0); PG8_MMA(1, 0, At, B0); PG8_BAR; PG8_SCHED;
            PG8_STAGE(PG8_SB(0, 1), b2 + hstep, voffB);
            PG8_WAIT_V(6); PG8_BAR; PG8_MMA(1, 1, At, B1); PG8_BAR;
            PG8_LDB(B0, 1, 0); PG8_SCHED; PG8_LDA(At, 1, 0); PG8_STAGE(PG8_SA(0, 1), a2 + hstep, voffA);
            PG8_WAIT_L(8); PG8_BAR; PG8_WAIT_L(0); PG8_MMA(0, 0, At, B0); PG8_BAR; PG8_SCHED;
            PG8_LDB(B1, 1, 1); PG8_STAGE(PG8_SB(1, 0), b3, voffB);
            PG8_BAR; PG8_WAIT_L(0); PG8_MMA(0, 1, At, B1); PG8_BAR;
            PG8_LDA(At, 1, 1); PG8_STAGE(PG8_SA(1, 0), a3, voffA);
            PG8_BAR; PG8_WAIT_L(0); PG8_MMA(1, 0, At, B0); PG8_BAR; PG8_SCHED;
            PG8_STAGE(PG8_SB(1, 1), b3 + hstep, voffB);
            PG8_WAIT_V(6); PG8_BAR; PG8_MMA(1, 1, At, B1); PG8_BAR;
        }
        if constexpr (!Epi::AFTER_DRAIN) { E(acc, cur, wr, wc, fr, fq); S.done(cur); }
        if (!has_next) break;
#pragma unroll
        for (int a = 0; a < 2; ++a)
#pragma unroll
            for (int b = 0; b < 2; ++b)
#pragma unroll
                for (int m = 0; m < 4; ++m)
#pragma unroll
                    for (int n = 0; n < 2; ++n) acc[a][b][m][n] = (f32x4){0.f, 0.f, 0.f, 0.f};
        cur = nxt; cA = nA; cB = nB; ++ui;
    }
    PG8_WAIT_V(0);
    if (wr == 0) PG8_BAR;
    PG8_BAR;
    if constexpr (Epi::AFTER_DRAIN) { E.fused(acc, cur, wr, wc, fr, fq, lds, wid, lane); S.done(cur); }
#undef PG8_SA
#undef PG8_SB
#undef PG8_STAGE
#undef PG8_LDA
#undef PG8_LDB
#undef PG8_MMA
#undef PG8_WAIT_V
#undef PG8_WAIT_L
#undef PG8_BAR
#undef PG8_SCHED
}
}

namespace att {
constexpr int D = 128, NW = 8, QBLK = 32, KVBLK = 64;
constexpr float SCALE = 0.088388347648318440f;
constexpr float THR = 8.f;
#ifndef ATT_SDEPTH
#define ATT_SDEPTH 1
#endif
constexpr int SDEPTH = ATT_SDEPTH;
constexpr int LD = 8192;
constexpr size_t SHM_V = KVBLK * D * 2, SHM_K = KVBLK * D * 2, SHM_ATTN = 2 * SHM_V + 2 * SHM_K + NW * 64 * 4;
#define KSWZ(row, colB) ((row) * 256 + ((colB) ^ (((row) & 7) << 4)))
#define SBAR() __builtin_amdgcn_sched_barrier(0)
__device__ __forceinline__ int crow(int r, int hi) { return (r & 3) + 8 * (r >> 2) + 4 * hi; }
__device__ __forceinline__ unsigned cvtpk(float lo, float hi) {
  unsigned r; asm volatile("v_cvt_pk_bf16_f32 %0, %1, %2" : "=v"(r) : "v"(lo), "v"(hi)); return r;
}
__device__ __forceinline__ void partialSM(f32x16& p0, f32x16& p1, float& m_reg, float& mn, float& alpha) {
  constexpr float C = SCALE * 1.4426950408889634f;
  float pmax = p0[0]; for (int r = 1; r < 16; ++r) pmax = fmaxf(pmax, p0[r]); for (int r = 0; r < 16; ++r) pmax = fmaxf(pmax, p1[r]);
  { auto rr = __builtin_amdgcn_permlane32_swap(__float_as_uint(pmax), __float_as_uint(pmax), false, false);
    pmax = fmaxf(__uint_as_float(rr[0]), __uint_as_float(rr[1])); }
  if (__builtin_expect(__all(pmax - m_reg <= THR / SCALE), 1)) { mn = m_reg; alpha = 1.f; }
  else { mn = fmaxf(m_reg, pmax); alpha = __builtin_amdgcn_exp2f((m_reg - mn) * C); m_reg = mn; }
  float mnC = -mn * C;
  for (int r = 0; r < 16; ++r) p0[r] = fmaf(p0[r], C, mnC); for (int r = 0; r < 16; ++r) p1[r] = fmaf(p1[r], C, mnC);
  for (int r = 0; r < 16; ++r) p0[r] = __builtin_amdgcn_exp2f(p0[r]);
}
__device__ __forceinline__ void finishSM(f32x16& p0, f32x16& p1, float alpha, float& l_reg, bf16x8& pa0, bf16x8& pa1, bf16x8& pa2, bf16x8& pa3) {
  for (int r = 0; r < 16; ++r) p1[r] = __builtin_amdgcn_exp2f(p1[r]);
  float ps = 0; for (int r = 0; r < 16; ++r) ps += p0[r]; for (int r = 0; r < 16; ++r) ps += p1[r];
  { auto rr = __builtin_amdgcn_permlane32_swap(__float_as_uint(ps), __float_as_uint(ps), false, false);
    ps = __uint_as_float(rr[0]) + __uint_as_float(rr[1]); }
  l_reg = l_reg * alpha + ps;
#define PK4(P, BASE, OUT) do { unsigned a0 = cvtpk(P[BASE + 0], P[BASE + 1]), a1 = cvtpk(P[BASE + 2], P[BASE + 3]);   \
    unsigned b0 = cvtpk(P[BASE + 4], P[BASE + 5]), b1 = cvtpk(P[BASE + 6], P[BASE + 7]);                              \
    auto r0 = __builtin_amdgcn_permlane32_swap(a0, b0, false, false); auto r1 = __builtin_amdgcn_permlane32_swap(a1, b1, false, false); \
    u32x4 w = {r0[0], r1[0], r0[1], r1[1]}; OUT = *reinterpret_cast<bf16x8*>(&w); } while (0)
  PK4(p0, 0, pa0); PK4(p0, 8, pa1); PK4(p1, 0, pa2); PK4(p1, 8, pa3);
#undef PK4
}
__device__ __forceinline__ void qkt(f32x16& p0, f32x16& p1, const bf16_t* Ks, const bf16x8* qr, int r32, int hi) {
  p0 = f32x16{}; p1 = f32x16{};
  for (int d0 = 0; d0 < 8; ++d0) { int cb = (d0 * 16 + hi * 8) * 2;
    bf16x8 b0 = *reinterpret_cast<const bf16x8*>((const char*)Ks + KSWZ(r32, cb));
    bf16x8 b1 = *reinterpret_cast<const bf16x8*>((const char*)Ks + KSWZ(32 + r32, cb));
    p0 = __builtin_amdgcn_mfma_f32_32x32x16_bf16(b0, qr[d0], p0, 0, 0, 0);
    p1 = __builtin_amdgcn_mfma_f32_32x32x16_bf16(b1, qr[d0], p1, 0, 0, 0); }
}
__device__ __forceinline__ int v_st(int k, int c) { const int kk = (k & ~0xC) | ((k & 4) << 1) | ((k & 8) >> 1); return ((kk >> 3) * 4 + (c >> 5)) * 512 + ((kk & 7) * 32 + (c & 31)) * 2; }
__device__ __forceinline__ int v_rd_base(int lane) { return ((lane & 3) << 3) | (((lane >> 2) & 3) << 6) | (((lane >> 4) & 1) << 5) | (((lane >> 5) & 1) << 8); }
constexpr int v_rd_off(int d0, int ks, int half) { return d0 * 512 + ks * 4096 + half * 2048; }
template <int OFF> __device__ __forceinline__ s16x4 tr_read(int vb) {
  s16x4 r; asm volatile("ds_read_b64_tr_b16 %0, %1 offset:%2" : "=&v"(r) : "v"(vb), "i"(OFF) : "memory"); return r;
}
template <int D0> __device__ __forceinline__ void pv_one(f32x16& od, int vb, bf16x8 pa0, bf16x8 pa1, bf16x8 pa2, bf16x8 pa3) {
  const s16x4 l0 = tr_read<v_rd_off(D0, 0, 0)>(vb), h0 = tr_read<v_rd_off(D0, 0, 1)>(vb), l1 = tr_read<v_rd_off(D0, 1, 0)>(vb), h1 = tr_read<v_rd_off(D0, 1, 1)>(vb);
  const s16x4 l2 = tr_read<v_rd_off(D0, 2, 0)>(vb), h2 = tr_read<v_rd_off(D0, 2, 1)>(vb), l3 = tr_read<v_rd_off(D0, 3, 0)>(vb), h3 = tr_read<v_rd_off(D0, 3, 1)>(vb);
  asm volatile("s_waitcnt lgkmcnt(0)" ::: "memory"); SBAR();
#define PK(L, H) (bf16x8){L[0], L[1], L[2], L[3], H[0], H[1], H[2], H[3]}
  od = __builtin_amdgcn_mfma_f32_32x32x16_bf16(pa0, PK(l0, h0), od, 0, 0, 0);
  od = __builtin_amdgcn_mfma_f32_32x32x16_bf16(pa1, PK(l1, h1), od, 0, 0, 0);
  od = __builtin_amdgcn_mfma_f32_32x32x16_bf16(pa2, PK(l2, h2), od, 0, 0, 0);
  od = __builtin_amdgcn_mfma_f32_32x32x16_bf16(pa3, PK(l3, h3), od, 0, 0, 0);
#undef PK
}
__device__ __forceinline__ void pv_d0(f32x16* o, int vb, bf16x8 pa0, bf16x8 pa1, bf16x8 pa2, bf16x8 pa3) {
  pv_one<0>(o[0], vb, pa0, pa1, pa2, pa3); pv_one<1>(o[1], vb, pa0, pa1, pa2, pa3); pv_one<2>(o[2], vb, pa0, pa1, pa2, pa3); pv_one<3>(o[3], vb, pa0, pa1, pa2, pa3);
}

}

constexpr int DM = 4096, NMETA = 16;
constexpr int NSEQ_A = 8, L_A = 2064, LP_A = 2112, TP_A = NSEQ_A * LP_A;
constexpr int NSEQ_B = 2, L_B = 8208, LP_B = 8320, TP_B = NSEQ_B * LP_B;
constexpr int TPMAX = TP_A, LPMAX = LP_B;
constexpr float NORM_EPS = 1e-6f;
constexpr float LAMBDA_INIT = 0.35550906f;
static_assert(TP_A % 256 == 0 && TP_B % 256 == 0 && LP_A % 64 == 0 && LP_B % 64 == 0, "padding");

constexpr size_t MiB = 1u << 20;
constexpr size_t WS_CTL = 0, CTL_ZERO_BYTES = 1 * MiB;
constexpr size_t WS_COSR = 1 * MiB;
constexpr size_t WS_SINR = WS_COSR + (size_t)LPMAX * 128 * 4;
constexpr size_t WS_COSD = WS_SINR + (size_t)LPMAX * 128 * 4;
constexpr size_t WS_SIND = WS_COSD + (size_t)LPMAX * 16 * 4;
constexpr size_t WS_XM = 12 * MiB;
constexpr size_t WS_W = 16 * MiB;
constexpr size_t WS_H = 336 * MiB;
constexpr size_t WS_R = 472 * MiB, RS = (size_t)TPMAX * 8192 * 2;
constexpr size_t WS_H2 = WS_R + 5 * RS;
constexpr size_t WS_END = WS_H2 + (size_t)TPMAX * 4096 * 2;
static_assert(WS_SIND + (size_t)LPMAX * 16 * 4 <= WS_XM && WS_XM + 10 * 16 * 4096 * 4 <= WS_W && WS_W + 320 * MiB <= WS_H && WS_H + (size_t)TPMAX * 4096 * 2 <= WS_R, "ws map");
constexpr int CW_BAR = 4096;
constexpr int MAX_LAUNCHES = 48;

#define XB_TMO      128
#define XB_XCNT(j)  (256  + 64 * (j))
#define XB_XSUB(j)  (1280 + 64 * (j))
#define XB_XGEN(j)  (2304 + 64 * (j))
#define XB_TOP      3328
#define XB_TOPGEN   3392
#define XCD_BAR_WORDS 3456
#define XB_SPIN_CAP (1u << 18)
static_assert((CW_BAR + MAX_LAUNCHES * XCD_BAR_WORDS) * 4 <= (int)CTL_ZERO_BYTES, "barrier regions inside the memset");
__device__ __forceinline__ unsigned xb_ld(unsigned* p)              { return __hip_atomic_load(p, __ATOMIC_RELAXED, __HIP_MEMORY_SCOPE_AGENT); }
__device__ __forceinline__ unsigned xb_add(unsigned* p, unsigned v) { return __hip_atomic_fetch_add(p, v, __ATOMIC_RELAXED, __HIP_MEMORY_SCOPE_AGENT); }
__device__ __forceinline__ unsigned xb_xcc_id() { return (unsigned)__builtin_amdgcn_s_getreg((3 << 11) | 20) & 0xFu; }
#define XB_SPIN(cond, bar) do { unsigned _sp = 0; while (cond) { __builtin_amdgcn_s_sleep(1); \
    if ((++_sp & 255u) == 0u) { if (xb_ld(&(bar)[XB_TMO])) break; if (_sp > XB_SPIN_CAP) { atomicAdd(&(bar)[XB_TMO], 1u); break; } } } } while (0)
struct XcdBarrier { unsigned* bar; unsigned x; volatile LAS unsigned* st; int wave; };
__device__ __forceinline__ int lane_id_now() { int l; asm volatile("v_mbcnt_lo_u32_b32 %0, -1, 0\n\tv_mbcnt_hi_u32_b32 %0, -1, %0" : "=v"(l)); return l; }
__device__ __forceinline__ bool xb_thread0(int wave) { return wave == 0 && lane_id_now() == 0; }
__device__ __forceinline__ XcdBarrier xcd_barrier_post(unsigned* bar, volatile LAS unsigned* st, int wave) {
    XcdBarrier b; b.bar = bar; b.x = xb_xcc_id(); b.st = st; b.wave = wave;
    if (xb_thread0(wave)) (void)xb_add(&bar[XB_XCNT(b.x)], 1u);
    return b;
}
__device__ __forceinline__ void xcd_barrier_complete(unsigned* bar, unsigned x, unsigned& nloc, unsigned& nx) {
    const unsigned G = gridDim.x * gridDim.y * gridDim.z;
    unsigned sum, cnt, mine, sp = 0u;
    for (;;) {
        sum = 0u; cnt = 0u; mine = 0u;
#pragma unroll
        for (unsigned j = 0; j < 16; ++j) { const unsigned c = xb_ld(&bar[XB_XCNT(j)]); sum += c; cnt += (c > 0u) ? 1u : 0u; mine = (j == x) ? c : mine; }
        if (sum == G) break;
        __builtin_amdgcn_s_sleep(1);
        if ((++sp & 255u) == 0u) { if (xb_ld(&bar[XB_TMO])) break; if (sp > XB_SPIN_CAP) { atomicAdd(&bar[XB_TMO], 1u); break; } }
    }
    nloc = mine > 0u ? mine : 1u; nx = cnt > 0u ? cnt : 1u;
}
__device__ __forceinline__ void xcd_barrier(const XcdBarrier& b) {
    asm volatile("s_waitcnt vmcnt(0)" ::: "memory");
    __syncthreads();
    if (xb_thread0(b.wave)) {
        unsigned* bar = b.bar; unsigned bx = b.x; asm volatile("" : "+s"(bx));
        __builtin_amdgcn_s_waitcnt(0);
        unsigned nloc = b.st[0], nx = b.st[1];
        if (nloc == 0u) { xcd_barrier_complete(bar, bx, nloc, nx); b.st[0] = nloc; b.st[1] = nx; }
        const unsigned old = xb_add(&bar[XB_XSUB(bx)], 1u);
        const unsigned gen = old / nloc;
        if (old + 1u == (gen + 1u) * nloc) {
            __builtin_amdgcn_fence(__ATOMIC_RELEASE, "agent");
            asm volatile("s_waitcnt vmcnt(0)" ::: "memory");
            const unsigned og = xb_add(&bar[XB_TOP], 1u);
            const unsigned tg = og / nx;
            if (og + 1u == (tg + 1u) * nx) xb_add(&bar[XB_TOPGEN], 1u);
            else XB_SPIN(xb_ld(&bar[XB_TOPGEN]) == tg, bar);
            __builtin_amdgcn_fence(__ATOMIC_ACQUIRE, "agent");
            xb_add(&bar[XB_XGEN(bx)], 1u);
            asm volatile("s_waitcnt vmcnt(0)" ::: "memory");
        } else {
            XB_SPIN(xb_ld(&bar[XB_XGEN(bx)]) == gen, bar);
            __builtin_amdgcn_fence(__ATOMIC_ACQUIRE, "agent");
            asm volatile("s_waitcnt vmcnt(0)" ::: "memory");
        }
    }
    __syncthreads();
}

__device__ __forceinline__ void xcd_barrier_nc(const XcdBarrier& b) {
    asm volatile("s_waitcnt vmcnt(0)" ::: "memory");
    __syncthreads();
    if (xb_thread0(b.wave)) {
        unsigned* bar = b.bar; unsigned bx = b.x; asm volatile("" : "+s"(bx));
        __builtin_amdgcn_s_waitcnt(0);
        unsigned nloc = b.st[0], nx = b.st[1];
        const unsigned old = xb_add(&bar[XB_XSUB(bx)], 1u);
        const unsigned gen = old / nloc;
        if (old + 1u == (gen + 1u) * nloc) {
            __builtin_amdgcn_fence(__ATOMIC_RELEASE, "agent");
            asm volatile("s_waitcnt vmcnt(0)" ::: "memory");
            const unsigned og = xb_add(&bar[XB_TOP], 1u);
            const unsigned tg = og / nx;
            if (og + 1u == (tg + 1u) * nx) xb_add(&bar[XB_TOPGEN], 1u);
            else XB_SPIN(xb_ld(&bar[XB_TOPGEN]) == tg, bar);
            __builtin_amdgcn_fence(__ATOMIC_ACQUIRE, "agent");
            xb_add(&bar[XB_XGEN(bx)], 1u);
            asm volatile("s_waitcnt vmcnt(0)" ::: "memory");
        } else {
            XB_SPIN(xb_ld(&bar[XB_XGEN(bx)]) == gen, bar);
            __builtin_amdgcn_fence(__ATOMIC_ACQUIRE, "agent");
            asm volatile("s_waitcnt vmcnt(0)" ::: "memory");
        }
    }
    __syncthreads();
}

constexpr int RING_BYTES = 131072;
constexpr int MISC_OFF = RING_BYTES;
constexpr int LDS_BYTES = 151552;

struct Grp { int nseq, L, LP, TP, seq0; const float* x; float* y; };
struct Frame {
    LAS unsigned char* lds; char* ldsg;
    int tid, lane, wave, gw, ngw, G;
    unsigned char* ws;
};

__device__ __forceinline__ void transpose_item(const float* __restrict__ W, int K, int N, bf16_t* __restrict__ WT, LAS float* scr, int item, int lane) {
    const int nblk = N / 32, kb = item / nblk, nb = item % nblk, k0 = 64 * kb, n0 = 32 * nb;
#pragma unroll 8
    for (int i = 0; i < 32; ++i) { const int kk = 2 * i + (lane >> 5); scr[kk * 33 + (lane & 31)] = W[(size_t)(k0 + kk) * N + n0 + (lane & 31)]; }
    LDS_WAIT(); asm volatile("" ::: "memory");
    const int c = lane & 7;
#pragma unroll
    for (int j = 0; j < 4; ++j) { const int n = (lane >> 3) + 8 * j; const LAS float* s = scr + (8 * c) * 33 + n;
        u32x4 o; o.x = pkbf(s[0 * 33], s[1 * 33]); o.y = pkbf(s[2 * 33], s[3 * 33]); o.z = pkbf(s[4 * 33], s[5 * 33]); o.w = pkbf(s[6 * 33], s[7 * 33]);
        *(u32x4*)(WT + (size_t)(n0 + n) * K + k0 + 8 * c) = o; }
    LDS_WAIT(); asm volatile("" ::: "memory");
}
__device__ __forceinline__ void phase_weights(Frame& F, const float* Win, int Nin, const float* Wout) {
    LAS float* scr = (LAS float*)(F.lds + F.wave * 16384);
    bf16_t* WinT = (bf16_t*)(F.ws + WS_W); bf16_t* WoutT = WinT + (size_t)Nin * DM;
    const int I1 = (DM / 64) * (Nin / 32), I2 = (8192 / 64) * (DM / 32);
    for (int it = F.gw; it < I1 + I2; it += F.ngw) {
        if (it < I1) transpose_item(Win, DM, Nin, WinT, scr, it, F.lane);
        else transpose_item(Wout, 8192, DM, WoutT, scr, it - I1, F.lane);
    }
}
__device__ __forceinline__ void sincos_rev(double rev, float& s, float& c) {
    rev -= floor(rev);
    const double k = floor(rev * 4.0 + 0.5);
    const double x = (rev - k * 0.25) * 6.283185307179586476925;
    const double x2 = x * x;
    const double sn = x * (1.0 + x2 * (-1.0 / 6 + x2 * (1.0 / 120 + x2 * (-1.0 / 5040 + x2 * (1.0 / 362880 + x2 * (-1.0 / 39916800))))));
    const double cs = 1.0 + x2 * (-0.5 + x2 * (1.0 / 24 + x2 * (-1.0 / 720 + x2 * (1.0 / 40320 + x2 * (-1.0 / 3628800 + x2 * (1.0 / 479001600))))));
    const int q = ((int)k) & 3;
    const double ss = q == 0 ? sn : q == 1 ? cs : q == 2 ? -sn : -cs;
    const double cc = q == 0 ? cs : q == 1 ? -sn : q == 2 ? -cs : sn;
    s = (float)ss; c = (float)cc;
}
__device__ __forceinline__ void phase_tables(Frame& F) {
    bf16_t* cosr = (bf16_t*)(F.ws + WS_COSR); bf16_t* sinr = (bf16_t*)(F.ws + WS_SINR); bf16_t* cosd = (bf16_t*)(F.ws + WS_COSD); bf16_t* sind = (bf16_t*)(F.ws + WS_SIND);
    const int gt = blockIdx.x * 512 + F.tid, ngt = F.G * 512;
    for (int i = gt; i < LPMAX * 128; i += ngt) { const int pos = i >> 7, fi = i & 127;
        const float inv = __builtin_exp2f(-(float)fi * (2.0f / 256.0f) * 13.287712379549449f);
        const float ang = (float)pos * inv; float s, c; sincos_rev((double)ang * 0.15915494309189533577, s, c); cosr[i] = (bf16_t)(pkbf(c, 0.f) & 0xffffu); sinr[i] = (bf16_t)(pkbf(s, 0.f) & 0xffffu); }
    for (int i = gt; i < LPMAX * 16; i += ngt) { const int pos = i >> 4, fi = i & 15;
        const float inv = __builtin_exp2f(-(float)fi * (2.0f / 32.0f) * 18.931568569324174f);
        const float ang = (float)pos * inv; float s, c; sincos_rev((double)ang * 0.15915494309189533577, s, c); cosd[i] = (bf16_t)(pkbf(c, 0.f) & 0xffffu); sind[i] = (bf16_t)(pkbf(s, 0.f) & 0xffffu); }
}
__device__ __forceinline__ const float* xrow_ptr(Frame& F, const Grp& g, const float* meta, int layer, int b, int pos) {
    if (layer == 0) return pos < NMETA ? meta + (size_t)pos * DM : g.x + ((size_t)b * (g.L - NMETA) + (pos - NMETA)) * DM;
    return pos < NMETA ? (const float*)(F.ws + WS_XM) + ((size_t)(g.seq0 + b) * NMETA + pos) * DM : g.y + ((size_t)b * (g.L - NMETA) + (pos - NMETA)) * DM;
}
__device__ __forceinline__ void phase_norm(Frame& F, const Grp& g, int layer, const float* meta, const float* pre) {
    bf16_t* H = (bf16_t*)(F.ws + WS_H); const f32x4* gain = (const f32x4*)(pre + (size_t)layer * DM);
    for (int row = F.gw; row < g.TP; row += F.ngw) {
        const int b = row / g.LP, pos = row - b * g.LP;
        u32x2* o8 = (u32x2*)(H + (size_t)row * DM) + F.lane;
        if (pos >= g.L) {
#pragma unroll
            for (int j = 0; j < 16; ++j) o8[64 * j] = (u32x2){0u, 0u};
            continue; }
        const f32x4* xr = (const f32x4*)xrow_ptr(F, g, meta, layer, b, pos) + F.lane;
        f32x4 v[16]; float s = 0.f;
#pragma unroll
        for (int j = 0; j < 16; ++j) v[j] = xr[64 * j];
#pragma unroll
        for (int j = 0; j < 16; ++j) { const f32x4 gn = gain[64 * j + F.lane]; s += (v[j].x * v[j].x + v[j].y * v[j].y) + (v[j].z * v[j].z + v[j].w * v[j].w); v[j] = v[j] * gn; }
        const float r = 1.0f / sqrtf(wave_sum(s) * (1.0f / DM) + NORM_EPS);
#pragma unroll
        for (int j = 0; j < 16; ++j) o8[64 * j] = (u32x2){pkbf(v[j].x * r, v[j].y * r), pkbf(v[j].z * r, v[j].w * r)};
    }
}
__device__ __forceinline__ void phase_post(Frame& F, const Grp& g, int layer, const bf16_t* Mbuf, const float* meta, const float* post, bf16_t* Hn, const float* pre) {
    const f32x4* gain = (const f32x4*)(post + (size_t)layer * DM); const f32x4* gain2 = (const f32x4*)(pre + (size_t)DM);
    for (int row = F.gw; row < g.TP; row += F.ngw) {
        const int b = row / g.LP, pos = row - b * g.LP;
        if (pos >= g.L) { if (layer == 0) { u32x2* o8 = (u32x2*)(Hn + (size_t)row * DM) + F.lane;
#pragma unroll
                for (int j = 0; j < 16; ++j) o8[64 * j] = (u32x2){0u, 0u}; }
            continue; }
        if (layer == 1 && pos < NMETA) continue;
        int ln = F.lane; asm volatile("" : "+v"(ln));
        const u32x2* mr = (const u32x2*)(Mbuf + (size_t)row * DM) + ln;
        float* yrow = g.y + ((size_t)b * (g.L - NMETA) + (pos - NMETA)) * DM;
        f32x4 v[16], x[16]; float s = 0.f;
#pragma unroll
        for (int j = 0; j < 16; ++j) { const u32x2 w = mr[64 * j]; v[j] = (f32x4){bflo(w.x), bfhi(w.x), bflo(w.y), bfhi(w.y)}; s += (v[j].x * v[j].x + v[j].y * v[j].y) + (v[j].z * v[j].z + v[j].w * v[j].w); }
        if (layer == 0) { const f32x4* xr = (const f32x4*)xrow_ptr(F, g, meta, 0, b, pos) + ln;
#pragma unroll
            for (int j = 0; j < 16; ++j) x[j] = xr[64 * j]; }
        else { const u32x2* xr = (const u32x2*)yrow + ln;
#pragma unroll
            for (int j = 0; j < 16; ++j) { const u32x2 w = xr[64 * j]; x[j] = (f32x4){bflo(w.x), bfhi(w.x), bflo(w.y), bfhi(w.y)}; } }
        const float r = 1.0f / sqrtf(wave_sum(s) * (1.0f / DM) + NORM_EPS);
        float s2 = 0.f;
#pragma unroll
        for (int j = 0; j < 16; ++j) { const f32x4 gn = gain[64 * j + ln];
            v[j] = (f32x4){x[j].x + v[j].x * r * gn.x, x[j].y + v[j].y * r * gn.y, x[j].z + v[j].z * r * gn.z, x[j].w + v[j].w * r * gn.w};
            s2 += (v[j].x * v[j].x + v[j].y * v[j].y) + (v[j].z * v[j].z + v[j].w * v[j].w); }
        if (layer == 1) asm volatile("s_waitcnt vmcnt(0)" ::: "memory");
        if (layer == 1 || pos < NMETA) {
            f32x4* dst = (layer == 1 ? (f32x4*)yrow : (f32x4*)((float*)(F.ws + WS_XM) + ((size_t)(g.seq0 + b) * NMETA + pos) * DM)) + ln;
#pragma unroll
            for (int j = 0; j < 16; ++j) dst[64 * j] = v[j];
        } else { u32x2* dst = (u32x2*)yrow + ln;
#pragma unroll
            for (int j = 0; j < 16; ++j) dst[64 * j] = (u32x2){pkbf(v[j].x, v[j].y), pkbf(v[j].z, v[j].w)}; }
        if (layer == 0) {
            const float r2 = 1.0f / sqrtf(wave_sum(s2) * (1.0f / DM) + NORM_EPS);
            u32x2* o8 = (u32x2*)(Hn + (size_t)row * DM) + ln;
#pragma unroll
            for (int j = 0; j < 16; ++j) { const f32x4 gn = gain2[64 * j + ln]; o8[64 * j] = (u32x2){pkbf(v[j].x * r2 * gn.x, v[j].y * r2 * gn.y), pkbf(v[j].z * r2 * gn.z, v[j].w * r2 * gn.w)}; }
        }
    }
}
__device__ __forceinline__ float silu_f(float g) { return g * __builtin_amdgcn_rcpf(1.0f + __builtin_amdgcn_exp2f(-g * 1.4426950408889634f)); }
__device__ __forceinline__ void phase_gate0(Frame& F, const Grp& g, bf16_t* OF, const bf16_t* OB, const bf16_t* G0) {
    const int nitems = g.TP * 16;
    for (int it0 = F.gw; it0 < nitems; it0 += 4 * F.ngw) {
        u32x4 a[4], bb[4], gg[4]; size_t off[4]; bool ok[4];
#pragma unroll
        for (int q = 0; q < 4; ++q) { const int it = it0 + q * F.ngw; const int itc = it < nitems ? it : it0;
            const int row = itc >> 4, hh = itc & 15; const int b = row / g.LP, pos = row - b * g.LP; ok[q] = it < nitems && pos < g.L;
            off[q] = (size_t)row * 8192 + hh * 512 + F.lane * 8;
            a[q] = *(const u32x4*)(OF + off[q]); bb[q] = *(const u32x4*)(OB + off[q]); gg[q] = *(const u32x4*)(G0 + off[q]); }
#pragma unroll
        for (int q = 0; q < 4; ++q) {
            float v[8]; float s = 0.f;
#pragma unroll
            for (int w = 0; w < 4; ++w) { v[2 * w] = bflo(a[q][w]) + bflo(bb[q][w]); v[2 * w + 1] = bfhi(a[q][w]) + bfhi(bb[q][w]); s += v[2 * w] * v[2 * w] + v[2 * w + 1] * v[2 * w + 1]; }
            const float r = 1.0f / sqrtf(wave_sum(s) * (1.0f / 512.0f) + NORM_EPS);
            u32x4 o;
#pragma unroll
            for (int w = 0; w < 4; ++w) o[w] = pkbf(v[2 * w] * r * silu_f(bflo(gg[q][w])), v[2 * w + 1] * r * silu_f(bfhi(gg[q][w])));
            if (ok[q]) *(u32x4*)(OF + off[q]) = o;
        }
    }
}


namespace att5 {
using att::crow; using att::partialSM; using att::finishSM; using att::qkt; using att::tr_read; using att::v_rd_base; using att::v_rd_off;
constexpr int LD2 = 8192 * 2;
constexpr int STAGE = 65536, K_IMG = 16384, V_OFF = 32768;
constexpr int SCR_OFF = MISC_OFF + 256;
static_assert(SCR_OFF + 8 * 256 <= LDS_BYTES, "att5 LDS");

#define ATT_TR8(P, D0) do { constexpr int B_ = ((D0) >> 2) * 16384 + ((D0) & 3) * 512; \
    P##l0 = tr_read<B_ + v_rd_off(0, 0, 0)>(vb); P##h0 = tr_read<B_ + v_rd_off(0, 0, 1)>(vb); P##l1 = tr_read<B_ + v_rd_off(0, 1, 0)>(vb); P##h1 = tr_read<B_ + v_rd_off(0, 1, 1)>(vb); \
    P##l2 = tr_read<B_ + v_rd_off(0, 2, 0)>(vb); P##h2 = tr_read<B_ + v_rd_off(0, 2, 1)>(vb); P##l3 = tr_read<B_ + v_rd_off(0, 3, 0)>(vb); P##h3 = tr_read<B_ + v_rd_off(0, 3, 1)>(vb); } while (0)
#define ATT_PK(L, H) (bf16x8){L[0], L[1], L[2], L[3], H[0], H[1], H[2], H[3]}
#define ATT_MM4(od, P) do { od = __builtin_amdgcn_mfma_f32_32x32x16_bf16(pa0, ATT_PK(P##l0, P##h0), od, 0, 0, 0); od = __builtin_amdgcn_mfma_f32_32x32x16_bf16(pa1, ATT_PK(P##l1, P##h1), od, 0, 0, 0); \
    od = __builtin_amdgcn_mfma_f32_32x32x16_bf16(pa2, ATT_PK(P##l2, P##h2), od, 0, 0, 0); od = __builtin_amdgcn_mfma_f32_32x32x16_bf16(pa3, ATT_PK(P##l3, P##h3), od, 0, 0, 0); } while (0)
#define ATT_W8() do { asm volatile("s_waitcnt lgkmcnt(8)" ::: "memory"); SBAR(); } while (0)
__device__ __forceinline__ void pv_pipe(f32x16 (&o)[8], int vb, bf16x8 pa0, bf16x8 pa1, bf16x8 pa2, bf16x8 pa3) {
  s16x4 Al0, Ah0, Al1, Ah1, Al2, Ah2, Al3, Ah3, Bl0, Bh0, Bl1, Bh1, Bl2, Bh2, Bl3, Bh3;
#define ATT_W0() do { asm volatile("s_waitcnt lgkmcnt(0)" ::: "memory"); SBAR(); } while (0)
  ATT_TR8(A, 0); ATT_W0(); ATT_MM4(o[0], A);
  ATT_TR8(B, 1); ATT_W0(); ATT_MM4(o[1], B);
  ATT_TR8(A, 2); ATT_W0(); ATT_MM4(o[2], A);
  ATT_TR8(B, 3); ATT_W0(); ATT_MM4(o[3], B);
  ATT_TR8(A, 4); ATT_W0(); ATT_MM4(o[4], A);
  ATT_TR8(B, 5); ATT_W0(); ATT_MM4(o[5], B);
  ATT_TR8(A, 6); ATT_W0(); ATT_MM4(o[6], A);
  ATT_TR8(B, 7); ATT_W0(); ATT_MM4(o[7], B);
#undef ATT_W0
}

#define ATT_KRD(dst, base, OFF) asm volatile("ds_read_b128 %0, %1 offset:%2" : "=&v"(dst) : "v"(base), "i"(OFF) : "memory")
__device__ __forceinline__ void qkt_pipe(f32x16& p0, f32x16& p1, unsigned ks, const bf16x8 (&qr)[8], int r32, int hi) {
  const unsigned x = r32 & 7, rowb = ks + r32 * 256 + 16u * (hi ^ (x & 1));
  const unsigned k0 = rowb + 32u * (0u ^ (x >> 1)), k1 = rowb + 32u * (1u ^ (x >> 1)), k2 = rowb + 32u * (2u ^ (x >> 1)), k3 = rowb + 32u * (3u ^ (x >> 1));
  bf16x8 a0, a1, b0, b1, c0, c1;
  p0 = f32x16{}; p1 = f32x16{};
  asm volatile("s_waitcnt lgkmcnt(0)" ::: "memory"); SBAR();
  ATT_KRD(a0, k0, 0); ATT_KRD(a1, k0, 8192); ATT_KRD(b0, k1, 0); ATT_KRD(b1, k1, 8192); ATT_KRD(c0, k2, 0); ATT_KRD(c1, k2, 8192);
#define ATT_QK(f0, f1, d0) do { p0 = __builtin_amdgcn_mfma_f32_32x32x16_bf16(f0, qr[d0], p0, 0, 0, 0); p1 = __builtin_amdgcn_mfma_f32_32x32x16_bf16(f1, qr[d0], p1, 0, 0, 0); } while (0)
#define ATT_W(n) do { asm volatile("s_waitcnt lgkmcnt(" #n ")" ::: "memory"); SBAR(); } while (0)
  ATT_W(4); ATT_QK(a0, a1, 0); SBAR(); ATT_KRD(a0, k3, 0);   ATT_KRD(a1, k3, 8192);
  ATT_W(4); ATT_QK(b0, b1, 1); SBAR(); ATT_KRD(b0, k0, 128); ATT_KRD(b1, k0, 8320);
  ATT_W(4); ATT_QK(c0, c1, 2); SBAR(); ATT_KRD(c0, k1, 128); ATT_KRD(c1, k1, 8320);
  ATT_W(4); ATT_QK(a0, a1, 3); SBAR(); ATT_KRD(a0, k2, 128); ATT_KRD(a1, k2, 8320);
  ATT_W(4); ATT_QK(b0, b1, 4); SBAR(); ATT_KRD(b0, k3, 128); ATT_KRD(b1, k3, 8320);
  ATT_W(4); ATT_QK(c0, c1, 5); SBAR();
  ATT_W(2); ATT_QK(a0, a1, 6); SBAR();
  ATT_W(0); ATT_QK(b0, b1, 7); SBAR();
#undef ATT_QK
#undef ATT_W
}
#undef ATT_KRD


#define A5_MFMA(a, b, c) __builtin_amdgcn_mfma_f32_32x32x16_bf16(a, b, c, 0, 0, 0)
#define A5_PIN(x) asm volatile("" : "+v"(x))
#define A5_KRD(dst, base, OFF) asm volatile("ds_read_b128 %0, %1 offset:%2" : "=&v"(dst) : "v"(base), "i"(OFF) : "memory")
#define A5_W(n) do { asm volatile("s_waitcnt lgkmcnt(" #n ")" ::: "memory"); SBAR(); } while (0)
#define A5_KO(i) (((((i) & 7) >> 2) * 128) + (((i) >> 3) * 8192))
#define A5_VO(D0, KS, H) (((D0) >> 2) * 16384 + ((D0) & 3) * 512 + v_rd_off(0, KS, H))
#define A5_VRD4(P, D0, KH) do { P##l0 = tr_read<A5_VO(D0, 2 * (KH), 0)>(vb); P##h0 = tr_read<A5_VO(D0, 2 * (KH), 1)>(vb); P##l1 = tr_read<A5_VO(D0, 2 * (KH) + 1, 0)>(vb); P##h1 = tr_read<A5_VO(D0, 2 * (KH) + 1, 1)>(vb); } while (0)
#define A5_FMA8(P, b) do { P[b] = __builtin_fmaf(P[b], C, nmC); \
    asm volatile("v_fma_f32 %1, %1, %8, %9\n\tv_fma_f32 %2, %2, %8, %9\n\tv_fma_f32 %3, %3, %8, %9\n\tv_fma_f32 %4, %4, %8, %9\n\tv_fma_f32 %5, %5, %8, %9\n\tv_fma_f32 %6, %6, %8, %9\n\tv_fma_f32 %7, %7, %8, %9" \
      : "+v"(P[b]), "+v"(P[b + 1]), "+v"(P[b + 2]), "+v"(P[b + 3]), "+v"(P[b + 4]), "+v"(P[b + 5]), "+v"(P[b + 6]), "+v"(P[b + 7]) : "s"(Cs), "v"(nmC)); } while (0)
#define A5_MAXALL(P) asm volatile("v_max3_f32 %0, %1, %2, %3\n\tv_max3_f32 %0, %0, %4, %5\n\tv_max3_f32 %0, %0, %6, %7\n\tv_max3_f32 %0, %0, %8, %9\n\tv_max3_f32 %0, %0, %10, %11\n\tv_max3_f32 %0, %0, %12, %13\n\tv_max3_f32 %0, %0, %14, %15\n\tv_max_f32 %0, %0, %16" \
      : "=&v"(mx) : "v"(P[0]), "v"(P[1]), "v"(P[2]), "v"(P[3]), "v"(P[4]), "v"(P[5]), "v"(P[6]), "v"(P[7]), "v"(P[8]), "v"(P[9]), "v"(P[10]), "v"(P[11]), "v"(P[12]), "v"(P[13]), "v"(P[14]), "v"(P[15]))
#define A5_DECIDE(P) do { { auto rr_ = __builtin_amdgcn_permlane32_swap(__float_as_uint(mx), __float_as_uint(mx), false, false); mx = __builtin_fmaxf(__uint_as_float(rr_[0]), __uint_as_float(rr_[1])); } \
    if (!__builtin_expect(__all(mx <= att::THR * 1.4426950408889634f) && !first, 1)) {     \
      const float dl_ = first ? mx : __builtin_fmaxf(mx, 0.f); const float al_ = first ? 0.f : __builtin_amdgcn_exp2f(-dl_); nmC -= dl_; l_reg *= al_; \
      _Pragma("unroll") for (int r_ = 0; r_ < 16; ++r_) P[r_] -= dl_; \
      if (hi == 0) al_l[r32] = al_; resc = !first; first = false; } } while (0)
#define A5_RESC() do { if (__builtin_expect(resc, 0)) { asm volatile("s_waitcnt lgkmcnt(0)" ::: "memory"); \
    _Pragma("unroll") for (int d = 0; d < 8; ++d) _Pragma("unroll") for (int r = 0; r < 16; ++r) o[d][r] *= al_l[crow(r, hi)]; resc = false; } } while (0)
#define A5_EXP2(P, k) do { P[2 * (k)] = __builtin_amdgcn_exp2f(P[2 * (k)]); P[2 * (k) + 1] = __builtin_amdgcn_exp2f(P[2 * (k) + 1]); } while (0)
#define A5_SUM(P, k) l_reg += (P[4 * (k)] + P[4 * (k) + 1]) + (P[4 * (k) + 2] + P[4 * (k) + 3])
#define A5_PK4(P, BASE, OUT) do { unsigned a0_ = att::cvtpk(P[BASE + 0], P[BASE + 1]), a1_ = att::cvtpk(P[BASE + 2], P[BASE + 3]); \
    unsigned b0_ = att::cvtpk(P[BASE + 4], P[BASE + 5]), b1_ = att::cvtpk(P[BASE + 6], P[BASE + 7]); \
    auto r0_ = __builtin_amdgcn_permlane32_swap(a0_, b0_, false, false); auto r1_ = __builtin_amdgcn_permlane32_swap(a1_, b1_, false, false); \
    u32x4 w_ = {r0_[0], r1_[0], r0_[1], r1_[1]}; OUT = __builtin_bit_cast(bf16x8, w_); } while (0)
template <int VARIANT>
__device__ __forceinline__ void unit(const bf16_t* __restrict__ Qp, bf16_t* __restrict__ Op, const bf16_t* __restrict__ Gp, const bf16_t* __restrict__ Kt, const bf16_t* __restrict__ Vt, int nt, int nvalid, int npad, float lam, const float* subln,
                                     LAS unsigned char* lds, char* ldsg, const int tid) {
  const int wid = __builtin_amdgcn_readfirstlane(tid >> 6), lane = tid & 63, r32 = lane & 31, hi = lane >> 5, m = wid >> 2, rw = wid & 3;
  float* wscr = (float*)(ldsg + SCR_OFF) + wid * 64; float* li_l = wscr; float* al_l = wscr + 32;
  const int img = (wid >> 1) & 1, isV = wid >> 2, ph8 = (wid & 1) * 8;
  const char* gsrc = isV ? (const char*)Vt : (const char*)Kt;
  const unsigned dst0 = (unsigned)(isV * V_OFF + img * K_IMG + ph8 * 1024);
#define ATT2_DMA(j) do { const char* tb_ = gsrc + (size_t)(j) * (64 * LD2); const unsigned db_ = ((j) & 1) * STAGE + dst0; \
    unsigned ln_ = lane; asm volatile("" : "+v"(ln_)); unsigned src_e, src_o;     \
    if (!isV) { const unsigned r4 = ln_ >> 4, cs = ln_ & 15;     \
      src_e = r4 * LD2 + img * 256 + 16u * (cs ^ (r4 & 7)); src_o = r4 * LD2 + img * 256 + 16u * (cs ^ ((4 + r4) & 7)); } \
    else { const unsigned t = (ln_ & 31) >> 2;                   \
      src_e = (8u * (t >> 2) + (t & 3)) * LD2 + img * 256 + 64u * (ln_ >> 5) + 16u * (ln_ & 3); src_o = src_e + 128u; } \
    _Pragma("unroll") for (int i = 0; i < 8; ++i) { const int pl = ph8 + i; \
      const unsigned uo = isV ? (unsigned)((16 * (pl >> 2) + 4 * ((pl >> 1) & 1)) * LD2) : (unsigned)(4 * pl * LD2); \
      __builtin_amdgcn_global_load_lds((const unsigned*)(tb_ + uo + ((i & 1) ? src_o : src_e)), (LAS unsigned*)(lds + db_ + i * 1024), 16, 0, 0); } } while (0)
#define A5_DMA_SETUP(jsrc, jst) const char* tb_ = gsrc + (size_t)(jsrc) * (64 * LD2); const unsigned db_ = ((jst) & 1) * STAGE + dst0; unsigned src_e, src_o; \
    { unsigned ln_ = lane; asm volatile("" : "+v"(ln_)); \
      if (!isV) { const unsigned r4 = ln_ >> 4, cs = ln_ & 15; src_e = r4 * LD2 + img * 256 + 16u * (cs ^ (r4 & 7)); src_o = r4 * LD2 + img * 256 + 16u * (cs ^ ((4 + r4) & 7)); } \
      else { const unsigned t = (ln_ & 31) >> 2; src_e = (8u * (t >> 2) + (t & 3)) * LD2 + img * 256 + 64u * (ln_ >> 5) + 16u * (ln_ & 3); src_o = src_e + 128u; } }
#define A5_DMAP(i) do { const int pl = ph8 + (i); const unsigned uo = isV ? (unsigned)((16 * (pl >> 2) + 4 * ((pl >> 1) & 1)) * LD2) : (unsigned)(4 * pl * LD2); \
    __builtin_amdgcn_global_load_lds((const unsigned*)(tb_ + uo + (((i) & 1) ? src_o : src_e)), (LAS unsigned*)(lds + db_ + (i) * 1024), 16, 0, 0); } while (0)
  bf16x8 qr[8];
  { const bf16_t* Qw = Qp + (size_t)(rw * 32 + r32) * 8192 + m * 128 + hi * 8;
#pragma unroll
    for (int d0 = 0; d0 < 8; ++d0) qr[d0] = *(const bf16x8*)(Qw + d0 * 16); }
  float nmC = 0.f, l_reg = 0.f; f32x16 o[8]; bool first = true;
#pragma unroll
  for (int d = 0; d < 8; ++d) o[d] = f32x16{};
  const int vbl = v_rd_base(lane) + V_OFF;
  const bool live = rw * 32 < nvalid;
  ATT2_DMA(0);
  for (int j = 0; j < nt; ++j) {
    asm volatile("s_waitcnt vmcnt(0) lgkmcnt(0)" ::: "memory"); __builtin_amdgcn_s_barrier(); asm volatile("" ::: "memory");
    const int jn = (j + 1 < nt) ? j + 1 : j;
    if (!live) { A5_DMA_SETUP(jn, j + 1); A5_DMAP(0); A5_DMAP(1); A5_DMAP(2); A5_DMAP(3); A5_DMAP(4); A5_DMAP(5); A5_DMAP(6); A5_DMAP(7); }
    if (live) {
      constexpr float C = att::SCALE * 1.4426950408889634f; const float Cs = C;
      f32x16 p0 = f32x16{}, p1 = f32x16{}; bf16x8 pa0, pa1, pa2, pa3; float mx; bool resc = false;
        const unsigned ks = (unsigned)((j & 1) * STAGE + m * K_IMG);
        const unsigned x = r32 & 7, rowb = ks + r32 * 256 + 16u * (hi ^ (x & 1));
        const unsigned k0 = rowb + 32u * (0u ^ (x >> 1)), k1 = rowb + 32u * (1u ^ (x >> 1)), k2 = rowb + 32u * (2u ^ (x >> 1)), k3 = rowb + 32u * (3u ^ (x >> 1));
        bf16x8 fa, fb, fc, fd;
        A5_KRD(fa, k0, A5_KO(0)); A5_KRD(fb, k1, A5_KO(1)); A5_KRD(fc, k2, A5_KO(2)); A5_KRD(fd, k3, A5_KO(3)); SBAR();
        A5_DMA_SETUP(jn, j + 1); asm volatile("" : "+v"(src_e), "+v"(src_o)); SBAR();
        A5_W(3); p0 = A5_MFMA(fa, qr[0], p0); A5_DMAP(0); SBAR(); A5_KRD(fa, k0, A5_KO(4));
        A5_W(3); p0 = A5_MFMA(fb, qr[1], p0); SBAR(); A5_KRD(fb, k1, A5_KO(5));
        A5_W(3); p0 = A5_MFMA(fc, qr[2], p0); A5_DMAP(1); SBAR(); A5_KRD(fc, k2, A5_KO(6));
        A5_W(3); p0 = A5_MFMA(fd, qr[3], p0); SBAR(); A5_KRD(fd, k3, A5_KO(7));
        A5_W(3); p0 = A5_MFMA(fa, qr[4], p0); A5_DMAP(2); SBAR(); A5_KRD(fa, k0, A5_KO(8));
        A5_W(3); p0 = A5_MFMA(fb, qr[5], p0); SBAR(); A5_KRD(fb, k1, A5_KO(9));
        A5_W(3); p0 = A5_MFMA(fc, qr[6], p0); SBAR(); A5_KRD(fc, k2, A5_KO(10));
        A5_W(3); p0 = A5_MFMA(fd, qr[7], p0); SBAR(); A5_KRD(fd, k3, A5_KO(11));
        A5_W(3); p1 = A5_MFMA(fa, qr[0], p1); A5_DMAP(3); SBAR();     A5_FMA8(p0, 0); SBAR(); A5_KRD(fa, k0, A5_KO(12));
        A5_W(3); p1 = A5_MFMA(fb, qr[1], p1); A5_FMA8(p0, 8); A5_MAXALL(p0); SBAR(); A5_KRD(fb, k1, A5_KO(13));
        A5_W(3); p1 = A5_MFMA(fc, qr[2], p1); A5_DECIDE(p0); A5_EXP2(p0, 0); A5_EXP2(p0, 1); A5_EXP2(p0, 2); A5_PIN(p0); SBAR(); A5_KRD(fc, k2, A5_KO(14));
        A5_W(3); p1 = A5_MFMA(fd, qr[3], p1); A5_EXP2(p0, 3); A5_EXP2(p0, 4); A5_EXP2(p0, 5); A5_PIN(p0); SBAR(); A5_KRD(fd, k3, A5_KO(15));
        A5_W(3); p1 = A5_MFMA(fa, qr[4], p1); A5_EXP2(p0, 6); A5_EXP2(p0, 7); A5_SUM(p0, 0); A5_PIN(p0); A5_PIN(l_reg); SBAR();
        A5_W(2); p1 = A5_MFMA(fb, qr[5], p1); A5_SUM(p0, 1); A5_PK4(p0, 0, pa0); A5_PIN(pa0); A5_PIN(l_reg); SBAR();
        A5_W(1); p1 = A5_MFMA(fc, qr[6], p1); A5_SUM(p0, 2); A5_SUM(p0, 3); A5_PIN(l_reg); SBAR();
        A5_W(0); p1 = A5_MFMA(fd, qr[7], p1); A5_PK4(p0, 8, pa1); A5_PIN(pa1); SBAR();
      A5_RESC();
      { const int vb = vbl + (j & 1) * STAGE;
        s16x4 Al0, Ah0, Al1, Ah1, Bl0, Bh0, Bl1, Bh1;
        A5_VRD4(A, 0, 0);
        A5_VRD4(B, 1, 0); A5_W(4); o[0] = A5_MFMA(pa0, ATT_PK(Al0, Ah0), o[0]); A5_FMA8(p1, 0); A5_DMAP(4); SBAR();              o[0] = A5_MFMA(pa1, ATT_PK(Al1, Ah1), o[0]); A5_FMA8(p1, 8); A5_DMAP(5); SBAR();
        A5_VRD4(A, 2, 0); A5_W(4); o[1] = A5_MFMA(pa0, ATT_PK(Bl0, Bh0), o[1]); A5_MAXALL(p1); A5_DMAP(6); SBAR();           o[1] = A5_MFMA(pa1, ATT_PK(Bl1, Bh1), o[1]); A5_DECIDE(p1); A5_PIN(p1); A5_DMAP(7); SBAR();
        A5_VRD4(B, 3, 0); A5_W(4); o[2] = A5_MFMA(pa0, ATT_PK(Al0, Ah0), o[2]); A5_EXP2(p1, 0); A5_PIN(p1); SBAR();           o[2] = A5_MFMA(pa1, ATT_PK(Al1, Ah1), o[2]); A5_EXP2(p1, 1); A5_PIN(p1); SBAR();
        A5_VRD4(A, 4, 0); A5_W(4); o[3] = A5_MFMA(pa0, ATT_PK(Bl0, Bh0), o[3]); A5_EXP2(p1, 2); A5_PIN(p1); SBAR();           o[3] = A5_MFMA(pa1, ATT_PK(Bl1, Bh1), o[3]); A5_EXP2(p1, 3); A5_PIN(p1); SBAR();
        A5_VRD4(B, 5, 0); A5_W(4); o[4] = A5_MFMA(pa0, ATT_PK(Al0, Ah0), o[4]); A5_EXP2(p1, 4); A5_PIN(p1); SBAR();           o[4] = A5_MFMA(pa1, ATT_PK(Al1, Ah1), o[4]); A5_EXP2(p1, 5); A5_PIN(p1); SBAR();
        A5_VRD4(A, 6, 0); A5_W(4); o[5] = A5_MFMA(pa0, ATT_PK(Bl0, Bh0), o[5]); A5_EXP2(p1, 6); A5_PIN(p1); SBAR();           o[5] = A5_MFMA(pa1, ATT_PK(Bl1, Bh1), o[5]); A5_EXP2(p1, 7); A5_PIN(p1); SBAR();
        A5_VRD4(B, 7, 0); A5_W(4); o[6] = A5_MFMA(pa0, ATT_PK(Al0, Ah0), o[6]); A5_PK4(p1, 0, pa2); A5_PIN(pa2); SBAR();   o[6] = A5_MFMA(pa1, ATT_PK(Al1, Ah1), o[6]); SBAR();
        A5_VRD4(A, 0, 1); A5_W(4); o[7] = A5_MFMA(pa0, ATT_PK(Bl0, Bh0), o[7]); A5_PK4(p1, 8, pa3); A5_PIN(pa3); SBAR();   o[7] = A5_MFMA(pa1, ATT_PK(Bl1, Bh1), o[7]); SBAR();
        A5_RESC();
        A5_VRD4(B, 1, 1); A5_W(4); o[0] = A5_MFMA(pa2, ATT_PK(Al0, Ah0), o[0]); o[0] = A5_MFMA(pa3, ATT_PK(Al1, Ah1), o[0]); A5_SUM(p1, 0); A5_PIN(l_reg); SBAR();
        A5_VRD4(A, 2, 1); A5_W(4); o[1] = A5_MFMA(pa2, ATT_PK(Bl0, Bh0), o[1]); o[1] = A5_MFMA(pa3, ATT_PK(Bl1, Bh1), o[1]); A5_SUM(p1, 1); A5_PIN(l_reg); SBAR();
        A5_VRD4(B, 3, 1); A5_W(4); o[2] = A5_MFMA(pa2, ATT_PK(Al0, Ah0), o[2]); o[2] = A5_MFMA(pa3, ATT_PK(Al1, Ah1), o[2]); A5_SUM(p1, 2); A5_PIN(l_reg); SBAR();
        A5_VRD4(A, 4, 1); A5_W(4); o[3] = A5_MFMA(pa2, ATT_PK(Bl0, Bh0), o[3]); o[3] = A5_MFMA(pa3, ATT_PK(Bl1, Bh1), o[3]); A5_SUM(p1, 3); A5_PIN(l_reg); SBAR();
        A5_VRD4(B, 5, 1); A5_W(4); o[4] = A5_MFMA(pa2, ATT_PK(Al0, Ah0), o[4]); o[4] = A5_MFMA(pa3, ATT_PK(Al1, Ah1), o[4]); SBAR();
        A5_VRD4(A, 6, 1); A5_W(4); o[5] = A5_MFMA(pa2, ATT_PK(Bl0, Bh0), o[5]); o[5] = A5_MFMA(pa3, ATT_PK(Bl1, Bh1), o[5]); SBAR();
        A5_VRD4(B, 7, 1); A5_W(4); o[6] = A5_MFMA(pa2, ATT_PK(Al0, Ah0), o[6]); o[6] = A5_MFMA(pa3, ATT_PK(Al1, Ah1), o[6]); SBAR();
                          A5_W(0); o[7] = A5_MFMA(pa2, ATT_PK(Bl0, Bh0), o[7]); o[7] = A5_MFMA(pa3, ATT_PK(Bl1, Bh1), o[7]); SBAR();
      }
    }
  }
  asm volatile("s_waitcnt vmcnt(0) lgkmcnt(0)" ::: "memory"); __builtin_amdgcn_s_barrier(); asm volatile("" ::: "memory");
  u32x4 gga[8];
  if (live) { int cb0 = lane + 512 * m; asm volatile("" : "+v"(cb0)); const int rmax = nvalid - 1 - rw * 32;
#pragma unroll
    for (int k = 0; k < 8; ++k) { const int c = cb0 + 64 * k, row = (c >> 5) < rmax ? (c >> 5) : rmax, col = 8 * (c & 31);
      gga[k] = *(const u32x4*)(Gp + (size_t)(rw * 32 + row) * 8192 + col); } }
  float rli[16];
  if (live) {
    { auto rr = __builtin_amdgcn_permlane32_swap(__float_as_uint(l_reg), __float_as_uint(l_reg), false, false); l_reg = __uint_as_float(rr[0]) + __uint_as_float(rr[1]); }
    { constexpr float C = att::SCALE * 1.4426950408889634f; l_reg -= (float)npad * __builtin_amdgcn_exp2f(nmC); }
    if (hi == 0) li_l[r32] = l_reg; asm volatile("s_waitcnt lgkmcnt(0)" ::: "memory");
#pragma unroll
    for (int r = 0; r < 16; ++r) rli[r] = __builtin_amdgcn_rcpf(li_l[crow(r, hi)]);
  }
  LAS float* Xb = (LAS float*)(lds + rw * 32768);
  LAS float* X = Xb + lane;
  if (live && m == 1) {
#pragma unroll
    for (int d = 0; d < 8; ++d)
#pragma unroll
      for (int r = 0; r < 16; ++r) X[(16 * d + r) * 64] = o[d][r] * rli[r];
  }
  asm volatile("s_waitcnt lgkmcnt(0)" ::: "memory"); __builtin_amdgcn_s_barrier(); asm volatile("" ::: "memory");
  if (live && m == 0) {
    float ss[16];
#pragma unroll
    for (int r = 0; r < 16; ++r) ss[r] = 0.f;
#pragma unroll
    for (int d = 0; d < 8; ++d)
#pragma unroll
      for (int r = 0; r < 16; ++r) { const float v = o[d][r] * rli[r] - lam * X[(16 * d + r) * 64]; o[d][r] = v; ss[r] += v * v; }
    int lx = lane << 2; asm volatile("" : "+v"(lx));
#define SHX(v, k) __builtin_bit_cast(float, __builtin_amdgcn_ds_bpermute(lx ^ ((k) << 2), __builtin_bit_cast(int, v)))
#pragma unroll
    for (int r = 0; r < 16; ++r) { float s = ss[r]; s += SHX(s, 1); s += SHX(s, 2); s += SHX(s, 4); s += SHX(s, 8); s += SHX(s, 16);
      ss[r] = (1.0f - LAMBDA_INIT) / sqrtf(s * (1.0f / 256.0f) + 1e-5f); }
#undef SHX
#pragma unroll
    for (int d = 0; d < 8; ++d) { const float sld = subln[d * 32 + r32];
#pragma unroll
      for (int r = 0; r < 16; ++r) Xb[crow(r, hi) * 256 + d * 32 + r32] = o[d][r] * ss[r] * sld; }
  }
  asm volatile("s_waitcnt lgkmcnt(0)" ::: "memory"); __builtin_amdgcn_s_barrier(); asm volatile("" ::: "memory");
  if (live) {
    int cb = lane + 512 * m; asm volatile("" : "+v"(cb));
#pragma unroll
    for (int k = 0; k < 8; ++k) { const int c = cb + 64 * k, row = c >> 5, col = 8 * (c & 31);
      if (rw * 32 + row < nvalid) {
        const f32x4 y0 = *(const LAS f32x4*)(Xb + row * 256 + col), y1 = *(const LAS f32x4*)(Xb + row * 256 + col + 4);
        const size_t go = (size_t)(rw * 32 + row) * 8192 + col;
        const u32x4 gg = gga[k];
        u32x4 w; w.x = pkbf(y0[0] * silu_f(bflo(gg.x)), y0[1] * silu_f(bfhi(gg.x))); w.y = pkbf(y0[2] * silu_f(bflo(gg.y)), y0[3] * silu_f(bfhi(gg.y)));
        w.z = pkbf(y1[0] * silu_f(bflo(gg.z)), y1[1] * silu_f(bfhi(gg.z))); w.w = pkbf(y1[2] * silu_f(bflo(gg.w)), y1[3] * silu_f(bfhi(gg.w)));
        *(u32x4*)(Op + go) = w; } }
  }
  asm volatile("s_waitcnt lgkmcnt(0)" ::: "memory"); __builtin_amdgcn_s_barrier(); asm volatile("" ::: "memory");
#undef ATT2_DMA
}
#undef A5_MFMA
#undef A5_DMA_SETUP
#undef A5_DMAP
#undef A5_PIN
#undef A5_KRD
#undef A5_W
#undef A5_KO
#undef A5_VO
#undef A5_VRD4
#undef A5_MX3
#undef A5_MAXALL
#undef A5_FMA8
#undef A5_DECIDE
#undef A5_RESC
#undef A5_EXP2
#undef A5_SUM
#undef A5_PK4
#undef ATT_TR8
#undef ATT_PK
#undef ATT_MM4
#undef ATT_W8
}

__device__ __forceinline__ unsigned img_off(unsigned row, unsigned ch) { return 2048u * (row >> 3) + 512u * (ch >> 2) + 64u * (row & 7) + 16u * ((ch & 3) ^ ((row >> 2) & 3)); }
__device__ __forceinline__ unsigned img_row_read(unsigned lane, unsigned s) { return img_off(lane & 31, 2 * s + (lane >> 5)); }
__device__ __forceinline__ unsigned img_tr_read(unsigned lane, unsigned c, unsigned ks, unsigned t) {
    const unsigned h = lane >> 5, blk = (lane >> 4) & 1, q = (lane & 15) >> 2, p = lane & 3;
    return img_off(16 * ks + 8 * h + 4 * t + q, 4 * c + 2 * blk + (p >> 1)) + 8 * (p & 1);
}
__device__ __forceinline__ unsigned img_row_read16(unsigned lane, unsigned rb, unsigned s) { return img_off((lane & 15) + 16 * rb, 4 * s + (lane >> 4)); }
__device__ __forceinline__ s16x4 ds_tr(unsigned addr) { s16x4 r; asm volatile("ds_read_b64_tr_b16 %0, %1" : "=&v"(r) : "v"(addr) : "memory"); return r; }
#define CAT8(L, H) (bf16x8){L[0], L[1], L[2], L[3], H[0], H[1], H[2], H[3]}

namespace ret {
constexpr int C = 64;
constexpr int QOFF = 0, KOFF = 32768, VOFF = 65536, VDOFF = 81920, POFF = 98304, OOFF = 114688;
static_assert(OOFF + 16384 <= RING_BYTES, "retention LDS");
constexpr int XOFF = MISC_OFF + 4096;
static_assert(XOFF + 16384 <= LDS_BYTES, "retention exchange");
__device__ __forceinline__ int crow(int r, int hi) { return (r & 3) + 8 * (r >> 2) + 4 * hi; }

__device__ __forceinline__ void chain(Frame& F, const Grp& g, int cid, const bf16_t* Q0, const bf16_t* K0, const bf16_t* V0,
                                      bf16_t* OF, bf16_t* OB, const float* dfw, const float* dbw) {
    const int es = cid & 3, dir = (cid >> 2) & 1, hh = (cid >> 3) & 15, b = cid >> 7;
    const int L = g.L; const size_t rowbase = (size_t)b * g.LP;
    const float lg2 = -__builtin_amdgcn_exp2f((dir ? dbw : dfw)[hh] * 1.4426950408889634f) * 1.4426950408889634f;
    const bf16_t* Qg = Q0 + hh * 256; const bf16_t* Kg = K0 + hh * 256; const bf16_t* Vg = V0 + hh * 512 + es * 128;
    bf16_t* Og = (dir ? OB : OF) + hh * 512 + es * 128;
    const int NC = (L + C - 1) / C;
    const int tid = F.tid, lane = F.lane, wid = F.wave, eb = wid & 3, ih = wid >> 2, h = lane >> 5, l31 = lane & 31;
    LAS unsigned char* lds = F.lds;
    const unsigned ldsb = 0u;
    f32x16 S[4];
#pragma unroll
    for (int i = 0; i < 4; ++i) S[i] = f32x16{};
    u32x4 pq[4], pk[4], pv[2];
    const float gC = __builtin_amdgcn_exp2f(lg2 * (float)C);
#define RET_LOAD(c) do { int tid_ = tid; asm volatile("" : "+v"(tid_)); _Pragma("unroll") for (int i = 0; i < 4; ++i) { const int p = tid_ + 512 * i, r = p >> 5, ch = p & 31; const int f = (c) * C + r; \
            const int pos = f < L ? (dir ? L - 1 - f : f) : L; const size_t go = (rowbase + pos) * 4096 + ch * 8; pq[i] = *(const u32x4*)(Qg + go); pk[i] = *(const u32x4*)(Kg + go); } \
        _Pragma("unroll") for (int i = 0; i < 2; ++i) { const int p = tid_ + 512 * i, r = p >> 4, ch = p & 15; const int f = (c) * C + r; \
            const int pos = f < L ? (dir ? L - 1 - f : f) : L; pv[i] = *(const u32x4*)(Vg + (rowbase + pos) * 8192 + ch * 8); } } while (0)
#define RET_WRITE() do { int tid_ = tid; asm volatile("" : "+v"(tid_)); _Pragma("unroll") for (int i = 0; i < 4; ++i) { const int p = tid_ + 512 * i, r = p >> 5, ch = p & 31; const unsigned o = ((r >> 5) * 2 + (ch >> 4)) * 8192 + img_off(r & 31, ch & 15); \
            *(LAS u32x4*)(lds + QOFF + o) = pq[i]; *(LAS u32x4*)(lds + KOFF + o) = pk[i]; } \
        _Pragma("unroll") for (int i = 0; i < 2; ++i) { const int p = tid_ + 512 * i, r = p >> 4, ch = p & 15; const unsigned o = (r >> 5) * 8192 + img_off(r & 31, ch); \
            *(LAS u32x4*)(lds + VOFF + o) = pv[i]; const float kd = __builtin_amdgcn_exp2f(lg2 * (float)(C - 1 - r)); u32x4 w; \
            _Pragma("unroll") for (int q = 0; q < 4; ++q) w[q] = pkbf(bflo(pv[i][q]) * kd, bfhi(pv[i][q]) * kd); \
            *(LAS u32x4*)(lds + VDOFF + o) = w; } } while (0)
    const unsigned l15 = lane & 15, g4 = lane >> 4, x2 = (l31 >> 2) & 3;
    const unsigned lp32 = 2048u * (l31 >> 3) + 64u * (l31 & 7);
    const unsigned rr16 = 2048u * (l15 >> 3) + 64u * (l15 & 7) + 16u * (g4 ^ ((l15 >> 2) & 3));
    const int it = wid & 3, jt0 = 2 * (wid >> 2);
    const unsigned kb16_0 = KOFF + (jt0 >> 1) * 16384 + rr16, kb16_1 = kb16_0 + 4096;
    const unsigned qb16 = QOFF + (it >> 1) * 16384 + (it & 1) * 4096 + rr16;
    const unsigned qxb = QOFF + (1 - ih) * 16384 + ih * 8192 + lp32 + 8u * h;
    const unsigned qx0 = qxb + 16u * (0u ^ x2), qx1 = qxb + 16u * (1u ^ x2), qx2 = qxb + 16u * (2u ^ x2), qx3 = qxb + 16u * (3u ^ x2);
    const unsigned xw = XOFF + (unsigned)wid * 2048u + (unsigned)lane * 16u, xr = XOFF + (unsigned)(wid ^ 4) * 2048u + (unsigned)lane * 16u;
    const unsigned pr_e = POFF + ih * 8192 + lp32 + 16u * ((0u + h) ^ x2), pr_o = POFF + ih * 8192 + lp32 + 16u * ((2u + h) ^ x2);
    const unsigned q4 = (lane & 15) >> 2, p3 = lane & 3, xx = 2u * ((lane >> 4) & 1) + (p3 >> 1);
    const unsigned tr0 = 2048u * h + 64u * q4 + 16u * (xx ^ (2u * h)) + 8u * (p3 & 1), tr1 = 2048u * h + 64u * q4 + 256u + 16u * (xx ^ (2u * h + 1u)) + 8u * (p3 & 1);
    const unsigned vtr0 = ldsb + VOFF + 512u * eb + tr0, vtr1 = ldsb + VOFF + 512u * eb + tr1;
    const unsigned vdtr0 = ldsb + VDOFF + 512u * eb + tr0, vdtr1 = ldsb + VDOFF + 512u * eb + tr1;
    const unsigned ktr0 = ldsb + KOFF + ih * 8192 + tr0, ktr1 = ldsb + KOFF + ih * 8192 + tr1;
    const int pi = 16 * it + (int)l15;
    const unsigned pw0 = POFF + (pi >> 5) * 8192 + img_off(pi & 31, (16 * jt0 + 4 * g4) >> 3) + ((4 * g4) & 7) * 2,
                   pw1 = POFF + (pi >> 5) * 8192 + img_off(pi & 31, (16 * (jt0 + 1) + 4 * g4) >> 3) + ((4 * g4) & 7) * 2;
#define TR(base, OFF) ({ s16x4 r_; asm volatile("ds_read_b64_tr_b16 %0, %1 offset:%2" : "=&v"(r_) : "v"(base), "i"(OFF) : "memory"); r_; })
    RET_LOAD(0);
    RET_WRITE();
    __syncthreads();
#pragma unroll 1
    for (int c = 0; c < NC; ++c) {
#define RD128(dst, base, OFF) asm volatile("ds_read_b128 %0, %1 offset:%2" : "=&v"(dst) : "v"(base), "i"(OFF) : "memory")
#define RD64(dst, base, OFF) asm volatile("ds_read_b64 %0, %1 offset:%2" : "=&v"(dst) : "v"(base), "i"(OFF) : "memory")
#define LW(n) do { asm volatile("s_waitcnt lgkmcnt(" #n ")" ::: "memory"); __builtin_amdgcn_sched_barrier(0); } while (0)
#define KSO(ks) (((ks) >> 2) * 8192 + ((ks) & 3) * 512)
        {
            f32x4 sacc0 = (f32x4){0.f, 0.f, 0.f, 0.f}, sacc1 = sacc0;
            bf16x8 xa0, xa1, xq, ya0, ya1, yq;
            LW(0);
#define SC_RD(P, ks) do { RD128(P##a0, kb16_0, KSO(ks)); RD128(P##a1, kb16_1, KSO(ks)); RD128(P##q, qb16, KSO(ks)); } while (0)
#define SC_MM(P) do { sacc0 = __builtin_amdgcn_mfma_f32_16x16x32_bf16(P##a0, P##q, sacc0, 0, 0, 0); sacc1 = __builtin_amdgcn_mfma_f32_16x16x32_bf16(P##a1, P##q, sacc1, 0, 0, 0); __builtin_amdgcn_sched_barrier(0); } while (0)
            SC_RD(x, 0); SC_RD(y, 1);
            LW(3); SC_MM(x); SC_RD(x, 2);
            LW(3); SC_MM(y); SC_RD(y, 3);
            LW(3); SC_MM(x); SC_RD(x, 4);
            LW(3); SC_MM(y); SC_RD(y, 5);
            LW(3); SC_MM(x); SC_RD(x, 6);
            LW(3); SC_MM(y); SC_RD(y, 7);
            LW(3); SC_MM(x);
            LW(0); SC_MM(y);
#undef SC_RD
#undef SC_MM
#pragma unroll
            for (int tt = 0; tt < 2; ++tt) {
                int dl0 = pi - (16 * (jt0 + tt) + 4 * (int)g4); asm volatile("" : "+v"(dl0));
                float p[4];
#pragma unroll
                for (int r = 0; r < 4; ++r) { const int dl = dl0 - r; const bool on = dl > 0 || (dl == 0 && dir == 0);
                    p[r] = on ? (tt ? sacc1[r] : sacc0[r]) * __builtin_amdgcn_exp2f(lg2 * (float)dl) : 0.f; }
                *(LAS u32x2*)(lds + (tt ? pw1 : pw0)) = (u32x2){pkbf(p[0], p[1]), pkbf(p[2], p[3])};
            }
        }
        f32x16 O = f32x16{};
        {
            u32x4 bw[4][2];
#pragma unroll
            for (int db = 0; db < 4; ++db)
#pragma unroll
                for (int s = 0; s < 2; ++s) { bw[db][s].x = pkbf(S[db][8 * s + 0], S[db][8 * s + 1]); bw[db][s].y = pkbf(S[db][8 * s + 2], S[db][8 * s + 3]); bw[db][s].z = pkbf(S[db][8 * s + 4], S[db][8 * s + 5]); bw[db][s].w = pkbf(S[db][8 * s + 6], S[db][8 * s + 7]); }
#define CR_RD(b0, b1, b2, b3, db) do { RD64(ql[2 * (db)], b0, (db) * 512); RD64(qh[2 * (db)], b1, (db) * 512); RD64(ql[2 * (db) + 1], b2, (db) * 512); RD64(qh[2 * (db) + 1], b3, (db) * 512); } while (0)
#define CR_MM(ACC, db) do { _Pragma("unroll") for (int s = 0; s < 2; ++s) { \
                    const u32x4 aw = (u32x4){ql[2 * (db) + s].x, ql[2 * (db) + s].y, qh[2 * (db) + s].x, qh[2 * (db) + s].y}; \
                    ACC = __builtin_amdgcn_mfma_f32_32x32x16_bf16(__builtin_bit_cast(bf16x8, aw), __builtin_bit_cast(bf16x8, bw[db][s]), ACC, 0, 0, 0); } } while (0)
            u32x2 ql[8], qh[8];
            f32x16 Op = f32x16{};
            CR_RD(qx0, qx1, qx2, qx3, 0); CR_RD(qx0, qx1, qx2, qx3, 1); CR_RD(qx0, qx1, qx2, qx3, 2); CR_RD(qx0, qx1, qx2, qx3, 3); LW(0);
            CR_MM(Op, 0); CR_MM(Op, 1); CR_MM(Op, 2); CR_MM(Op, 3); __builtin_amdgcn_sched_barrier(0);
            { const unsigned o0 = qx0 ^ 16384u, o1 = qx1 ^ 16384u, o2 = qx2 ^ 16384u, o3 = qx3 ^ 16384u;
              CR_RD(o0, o1, o2, o3, 0); CR_RD(o0, o1, o2, o3, 1); CR_RD(o0, o1, o2, o3, 2); CR_RD(o0, o1, o2, o3, 3); }
            { u32x4 w0, w1; w0.x = pkbf(Op[0], Op[1]); w0.y = pkbf(Op[2], Op[3]); w0.z = pkbf(Op[4], Op[5]); w0.w = pkbf(Op[6], Op[7]);
              w1.x = pkbf(Op[8], Op[9]); w1.y = pkbf(Op[10], Op[11]); w1.z = pkbf(Op[12], Op[13]); w1.w = pkbf(Op[14], Op[15]);
              LW(0);
              *(LAS u32x4*)(lds + xw) = w0; *(LAS u32x4*)(lds + xw + 1024) = w1; }
            CR_MM(O, 0); CR_MM(O, 1); CR_MM(O, 2); CR_MM(O, 3);
#undef CR_RD
#undef CR_MM
        }
#undef RD128
#undef RD64
#undef LW
#undef KSO
        __syncthreads();
        { const u32x4 w0 = *(const LAS u32x4*)(lds + xr), w1 = *(const LAS u32x4*)(lds + xr + 1024);
          O[0] += bflo(w0.x); O[1] += bfhi(w0.x); O[2] += bflo(w0.y); O[3] += bfhi(w0.y); O[4] += bflo(w0.z); O[5] += bfhi(w0.z); O[6] += bflo(w0.w); O[7] += bfhi(w0.w);
          O[8] += bflo(w1.x); O[9] += bfhi(w1.x); O[10] += bflo(w1.y); O[11] += bfhi(w1.y); O[12] += bflo(w1.z); O[13] += bfhi(w1.z); O[14] += bflo(w1.w); O[15] += bfhi(w1.w); }
        { int rb_ = 32 * ih + 4 * h + 1; asm volatile("" : "+v"(rb_));
#pragma unroll
          for (int r = 0; r < 16; ++r) O[r] *= __builtin_amdgcn_exp2f(lg2 * (float)(rb_ + (r & 3) + 8 * (r >> 2))); }
        {
            bf16x8 pa[4]; s16x4 vl[4], vh[4];
#pragma unroll
            for (int ks = 0; ks < 4; ++ks) pa[ks] = *(const LAS bf16x8*)(lds + ((ks & 1) ? pr_o : pr_e) + (ks >> 1) * 512);
            vl[0] = TR(vtr0, 0); vh[0] = TR(vtr1, 0); vl[1] = TR(vtr0, 4096); vh[1] = TR(vtr1, 4096);
            vl[2] = TR(vtr0, 8192); vh[2] = TR(vtr1, 8192); vl[3] = TR(vtr0, 12288); vh[3] = TR(vtr1, 12288);
            asm volatile("s_waitcnt lgkmcnt(0)" ::: "memory"); __builtin_amdgcn_sched_barrier(0);
#pragma unroll
            for (int ks = 0; ks < 4; ++ks) O = __builtin_amdgcn_mfma_f32_32x32x16_bf16(pa[ks], CAT8(vl[ks], vh[ks]), O, 0, 0, 0);
        }
        { int ob = OOFF + (32 * ih + 4 * h) * 256 + (32 * eb + l31) * 2; asm volatile("" : "+v"(ob));
#pragma unroll
          for (int r = 0; r < 16; ++r) *(LAS bf16_t*)(lds + ob + ((r & 3) + 8 * (r >> 2)) * 256) = (bf16_t)(pkbf(O[r], 0.f) & 0xffffu); }
        if (c + 1 < NC) RET_LOAD(c + 1);
#pragma unroll
        for (int db = 0; db < 4; ++db)
#pragma unroll
            for (int r = 0; r < 16; ++r) S[db][r] *= gC;
#define LWU(n) do { asm volatile("s_waitcnt lgkmcnt(" #n ")" ::: "memory"); __builtin_amdgcn_sched_barrier(0); } while (0)
#define UP_O(ks, dh, dq) ((((ks) >> 1) * 2) * 8192 + ((ks) & 1) * 4096 + (dq) * 512)
#define UP_RD(P, ks, dh) do { P##0l = TR(ktr0, UP_O(ks, dh, 0)); P##0h = TR(ktr1, UP_O(ks, dh, 0)); P##1l = TR(ktr0, UP_O(ks, dh, 1)); P##1h = TR(ktr1, UP_O(ks, dh, 1)); \
                              P##2l = TR(ktr0, UP_O(ks, dh, 2)); P##2h = TR(ktr1, UP_O(ks, dh, 2)); P##3l = TR(ktr0, UP_O(ks, dh, 3)); P##3h = TR(ktr1, UP_O(ks, dh, 3)); } while (0)
#define UP_RDB(Q, ks) do { Q##l = TR(vdtr0, ((ks) >> 1) * 8192 + ((ks) & 1) * 4096); Q##h = TR(vdtr1, ((ks) >> 1) * 8192 + ((ks) & 1) * 4096); } while (0)
#define UP_MM(P, Q, dh) do { S[4 * (dh) + 0] = __builtin_amdgcn_mfma_f32_32x32x16_bf16(CAT8(P##0l, P##0h), CAT8(Q##l, Q##h), S[4 * (dh) + 0], 0, 0, 0); \
                             S[4 * (dh) + 1] = __builtin_amdgcn_mfma_f32_32x32x16_bf16(CAT8(P##1l, P##1h), CAT8(Q##l, Q##h), S[4 * (dh) + 1], 0, 0, 0); \
                             S[4 * (dh) + 2] = __builtin_amdgcn_mfma_f32_32x32x16_bf16(CAT8(P##2l, P##2h), CAT8(Q##l, Q##h), S[4 * (dh) + 2], 0, 0, 0); \
                             S[4 * (dh) + 3] = __builtin_amdgcn_mfma_f32_32x32x16_bf16(CAT8(P##3l, P##3h), CAT8(Q##l, Q##h), S[4 * (dh) + 3], 0, 0, 0); __builtin_amdgcn_sched_barrier(0); } while (0)
        {
            s16x4 aA0l, aA0h, aA1l, aA1h, aA2l, aA2h, aA3l, aA3h, aB0l, aB0h, aB1l, aB1h, aB2l, aB2h, aB3l, aB3h, bAl, bAh, bBl, bBh;
            LWU(0);
            UP_RDB(bA, 0); UP_RD(aA, 0, 0);
            UP_RDB(bB, 1); UP_RD(aB, 1, 0);  LWU(10); UP_MM(aA, bA, 0);
            UP_RDB(bA, 2); UP_RD(aA, 2, 0);  LWU(10); UP_MM(aB, bB, 0);
            UP_RDB(bB, 3); UP_RD(aB, 3, 0);  LWU(10); UP_MM(aA, bA, 0);
                                             LWU(0);  UP_MM(aB, bB, 0);
        }
#undef LWU
#undef UP_O
#undef UP_RD
#undef UP_RDB
#undef UP_MM
        __syncthreads();
        { int t2 = tid; asm volatile("" : "+v"(t2));
#pragma unroll
          for (int i = 0; i < 2; ++i) { const int idx = t2 + 512 * i, row = idx >> 4, ch = idx & 15; const int f = c * C + row;
            if (f < L) { const int pos = dir ? L - 1 - f : f; *(u32x4*)(Og + (rowbase + pos) * 8192 + ch * 8) = *(const LAS u32x4*)(lds + OOFF + row * 256 + ch * 16); } } }
        if (c + 1 < NC) { RET_WRITE(); }
        __syncthreads();
    }
#undef TR
#undef RET_LOAD
#undef RET_WRITE
}
__device__ __forceinline__ void phase(Frame& F, const Grp& g, const bf16_t* Q0, const bf16_t* K0, const bf16_t* V0, bf16_t* OF, bf16_t* OB, const float* dfw, const float* dbw) {
    const int nx = (F.G & 7) ? 1 : 8;
    const int xcd = blockIdx.x % nx, slot = blockIdx.x / nx, nslot = F.G / nx, nlx = g.nseq * 128 / nx;
    for (int li = slot; li < nlx; li += nslot) { const int cid = ((li >> 3) * nx + xcd) * 8 + (li & 7); chain(F, g, cid, Q0, K0, V0, OF, OB, dfw, dbw); }
}
}
#ifndef ATT_NS
#define ATT_NS att5
#endif
#ifndef SPLITK
#define SPLITK 1
#endif

__device__ __forceinline__ void phase_reduce_tail(Frame& F, const Grp& g, bf16_t* Mbuf, const float* P) {
    pg8::StaticOrder S; S.init(g.TP, DM, 8192, F.G, (int)blockIdx.x, 1);
    const int nt = S.n_tail(); if (nt == 0 || (int)blockIdx.x >= nt * S.S) return;
    const int lu = (int)blockIdx.x / S.S, ks = (int)blockIdx.x - lu * S.S, rows = 256 / S.S;
    pg8::Unit u; S.tail_tile(lu, u);
    for (int i = F.tid; i < rows * 32; i += 512) { const int r = ks * rows + (i >> 5), c8 = (i & 31) * 8;
        const float* src = P + (size_t)(lu * S.S) * 65536 + r * 256 + c8; f32x4 a = (f32x4){0.f, 0.f, 0.f, 0.f}, b = a;
        for (int s = 0; s < S.S; ++s) { a += *(const f32x4*)(src + (size_t)s * 65536); b += *(const f32x4*)(src + (size_t)s * 65536 + 4); }
        u32x4 w; w.x = pkbf(a[0], a[1]); w.y = pkbf(a[2], a[3]); w.z = pkbf(b[0], b[1]); w.w = pkbf(b[2], b[3]);
        *(u32x4*)(Mbuf + (size_t)(u.pm * 256 + r) * DM + u.pn * 256 + c8) = w; }
}

template <int VARIANT>
__device__ __forceinline__ void phase_attn2(Frame& F, const Grp& g, const bf16_t* R0, const bf16_t* R1, const bf16_t* R2, const bf16_t* R3, bf16_t* R4,
                                            const float* lq1, const float* lk1, const float* lq2, const float* lk2, const float* subln) {
    float lam;
    { const float a = lq1[F.lane] * lk1[F.lane] + lq1[F.lane + 64] * lk1[F.lane + 64], c = lq2[F.lane] * lk2[F.lane] + lq2[F.lane + 64] * lk2[F.lane + 64];
      lam = __builtin_amdgcn_exp2f(wave_sum(a) * 1.4426950408889634f) - __builtin_amdgcn_exp2f(wave_sum(c) * 1.4426950408889634f) + LAMBDA_INIT; }
    const int NQF = g.L / 128, tail = (g.L % 128) != 0, nfull = g.nseq * 32 * NQF, nu = nfull + (tail ? g.nseq * 32 : 0);
    const int nt = (g.L + 63) / 64;
    const int npad = __builtin_amdgcn_readfirstlane(nt * 64 - g.L);
    const int nx = (F.G & 7) ? 1 : 8;
    const int xcd = blockIdx.x % nx, slot = blockIdx.x / nx, nslot = F.G / nx, npair8 = g.nseq * 32 / nx;
    const int nfx = npair8 * NQF, nux = nfx + (tail ? npair8 : 0);
    (void)nu; (void)nfull;
    for (int li = slot; li < nux; li += nslot) {
        const int qb = li < nfx ? li % NQF : NQF, t = (li < nfx ? li / NQF : li - nfx) * nx + xcd, hh = t & 31, b = t >> 5;
        const size_t seqrow = (size_t)b * g.LP, qoff = (seqrow + (size_t)qb * 128) * 8192 + (size_t)hh * 256, koff = seqrow * 8192 + (size_t)hh * 256;
        const int nvalid = (g.L - qb * 128) < 128 ? (g.L - qb * 128) : 128;
        ATT_NS::unit<VARIANT>(R0 + qoff, R4 + qoff, R3 + qoff, R1 + koff, R2 + koff, nt, nvalid, npad, lam, subln, F.lds, F.ldsg, F.tid);
    }
}

#ifndef REP_G1
#define REP_G1 1
#endif
#ifndef REP_G2
#define REP_G2 1
#endif
#ifndef REP_RET
#define REP_RET 1
#endif
#ifndef REP_ATT
#define REP_ATT 1
#endif
#ifndef G1_PROBE
#define G1_PROBE 0
#endif
#ifndef REP_W
#define REP_W 1
#endif

#ifndef ATT_PROBE
#define ATT_PROBE 0
#endif
constexpr int NPHASES = 22 + 4 * SPLITK + 4 * (REP_G1 - 1) + 4 * (REP_G2 - 1) + 2 * (REP_RET - 1) + 2 * (REP_ATT - 1) + 2 * (ATT_PROBE != 0) + 4 * G1_PROBE + 2 * (REP_W - 1);
struct Args { const float* in[16]; float* out; unsigned char* ws; int ph_lo, ph_hi, li, pad; };
__global__ void __launch_bounds__(512, 2) mk_fwd(Args args) {
    extern __shared__ __attribute__((aligned(16))) unsigned char lds_raw[];
    Frame F;
    F.lds = (LAS unsigned char*)lds_raw; F.ldsg = (char*)lds_raw;
    const int wave0 = __builtin_amdgcn_readfirstlane((int)threadIdx.x >> 6);
    F.wave = wave0; F.lane = lane_id_now(); F.tid = wave0 * 64 + F.lane;
    F.G = gridDim.x; F.gw = blockIdx.x * 8 + F.wave; F.ngw = F.G * 8;
    F.ws = args.ws;
    volatile LAS unsigned* MISC = (volatile LAS unsigned*)(F.lds + MISC_OFF);
    if (F.tid < 16) MISC[F.tid] = 0u;
    __syncthreads();
    unsigned* ctl = (unsigned*)(F.ws + WS_CTL);
    XcdBarrier bar = xcd_barrier_post(ctl + CW_BAR + args.li * XCD_BAR_WORDS, MISC + 8, wave0);
    xcd_barrier(bar);
    const int lo = args.ph_lo, hi = args.ph_hi;
    int ph = 0;
#define RUN(...) do { if (ph >= lo && ph < hi) { __builtin_amdgcn_s_waitcnt(0);   { int t_ = wave0 * 64 + lane_id_now(); asm volatile("" : "+v"(t_)); F.tid = t_; F.lane = t_ & 63; F.wave = wave0; F.gw = blockIdx.x * 8 + F.wave; } \
        __VA_ARGS__; if (ph + 1 < hi) xcd_barrier_nc(bar); } ++ph; } while (0)

    bf16_t* const H = (bf16_t*)(F.ws + WS_H);
    bf16_t* const R0 = (bf16_t*)(F.ws + WS_R), * const R1 = (bf16_t*)(F.ws + WS_R + RS), * const R2 = (bf16_t*)(F.ws + WS_R + 2 * RS), * const R3 = (bf16_t*)(F.ws + WS_R + 3 * RS), * const R4 = (bf16_t*)(F.ws + WS_R + 4 * RS);
    bf16_t* const WinT = (bf16_t*)(F.ws + WS_W);

#define GRP_A(g) Grp g; g.nseq = NSEQ_A; g.L = L_A; g.LP = LP_A; g.TP = TP_A; g.seq0 = 0; g.x = args.in[0]; g.y = args.out
#define GRP_B(g) Grp g; g.nseq = NSEQ_B; g.L = L_B; g.LP = LP_B; g.TP = TP_B; g.seq0 = NSEQ_A; g.x = args.in[1]; g.y = args.out + (size_t)NSEQ_A * (L_A - NMETA) * DM
    bf16_t* const Q0 = R0; bf16_t* const K0 = R0 + (size_t)TPMAX * 4096;
#define LAYER0(GRP, H1) do { GRP(g); \
        RUN(phase_norm(F, g, 0, args.in[2], args.in[3])); \
        if (G1_PROBE) RUN({ pg8::Gemm gm{H, WinT, g.TP, 24576, DM}; pg8::StaticOrder S; S.init(g.TP, 24576, DM, F.G, (int)blockIdx.x, 0); \
              pg8::EpiProj E{Q0, (size_t)TPMAX * 4096, 4096, 12, 8192, R1, RS / 2, 8192, 13}; pg8::gemm_phase<pg8::EpiProj, pg8::StaticOrder>(F.lds, gm, S, E, F.tid); });     \
        for (int rep = 0; rep < REP_G1; ++rep) \
        RUN({ pg8::Gemm gm{H, WinT, g.TP, 24576, DM}; pg8::StaticOrder S; S.init(g.TP, 24576, DM, F.G, (int)blockIdx.x, 0); \
              pg8::EpiProj E{Q0, (size_t)TPMAX * 4096, 4096, 12, 8192, R1, RS / 2, 8192, 13};     \
              pg8::EpiProjRope<0> ER{E, (const bf16_t*)(F.ws + WS_COSR), (const bf16_t*)(F.ws + WS_SINR), g.LP}; \
              pg8::gemm_phase<pg8::EpiProjRope<0>, pg8::StaticOrder>(F.lds, gm, S, ER, F.tid); }); \
        for (int rep = 0; rep < REP_RET; ++rep) \
        RUN(ret::phase(F, g, Q0, K0, R1, R3, R4, args.in[7], args.in[8])); \
        RUN(phase_gate0(F, g, R3, R4, R2)); \
        for (int rep = 0; rep < REP_G2; ++rep) \
        RUN({ pg8::Gemm gm{R3, WinT + (size_t)24576 * DM, g.TP, DM, 8192}; pg8::StaticOrder S; S.init(g.TP, DM, 8192, F.G, (int)blockIdx.x, SPLITK); \
              pg8::EpiM E{R0, DM, (float*)H};                                                      \
              pg8::gemm_phase<pg8::EpiM, pg8::StaticOrder>(F.lds, gm, S, E, F.tid); }); \
        if (SPLITK) RUN(phase_reduce_tail(F, g, R0, (const float*)H)); \
        RUN(phase_post(F, g, 0, R0, args.in[2], args.in[4], H1, args.in[3])); } while (0)
#define LAYER1(GRP, H1) do { GRP(g); \
        if (G1_PROBE) RUN({ pg8::Gemm gm{H1, WinT, g.TP, 32768, DM}; pg8::StaticOrder S; S.init(g.TP, 32768, DM, F.G, (int)blockIdx.x, 0); \
              pg8::EpiProj E{R0, RS / 2, 8192, 13, 0, R0, RS / 2, 8192, 13}; pg8::gemm_phase<pg8::EpiProj, pg8::StaticOrder>(F.lds, gm, S, E, F.tid); }); \
        for (int rep = 0; rep < REP_G1; ++rep) \
        RUN({ pg8::Gemm gm{H1, WinT, g.TP, 32768, DM}; pg8::StaticOrder S; S.init(g.TP, 32768, DM, F.G, (int)blockIdx.x, 0); \
              pg8::EpiProj E{R0, RS / 2, 8192, 13, 0, R0, RS / 2, 8192, 13};                         \
              pg8::EpiProjRope<1> ER{E, (const bf16_t*)(F.ws + WS_COSD), (const bf16_t*)(F.ws + WS_SIND), g.LP}; \
              pg8::gemm_phase<pg8::EpiProjRope<1>, pg8::StaticOrder>(F.lds, gm, S, ER, F.tid); }); \
        if (ATT_PROBE) RUN(phase_attn2<ATT_PROBE>(F, g, R0, R1, R2, R3, R4, args.in[11], args.in[12], args.in[13], args.in[14], args.in[15]));   \
        for (int rep = 0; rep < REP_ATT; ++rep) \
        RUN(phase_attn2<0>(F, g, R0, R1, R2, R3, R4, args.in[11], args.in[12], args.in[13], args.in[14], args.in[15])); \
        for (int rep = 0; rep < REP_G2; ++rep) \
        RUN({ pg8::Gemm gm{R4, WinT + (size_t)32768 * DM, g.TP, DM, 8192}; pg8::StaticOrder S; S.init(g.TP, DM, 8192, F.G, (int)blockIdx.x, SPLITK); \
              pg8::EpiM E{R1, DM, (float*)H1};                                                     \
              pg8::gemm_phase<pg8::EpiM, pg8::StaticOrder>(F.lds, gm, S, E, F.tid); }); \
        if (SPLITK) RUN(phase_reduce_tail(F, g, R1, (const float*)H1)); \
        RUN(phase_post(F, g, 1, R1, args.in[2], args.in[4], H1, args.in[3])); } while (0)
    for (int rep = 0; rep < REP_W; ++rep)
    RUN({ phase_tables(F); phase_weights(F, args.in[5], 24576, args.in[6]); });
    bf16_t* const H2 = (bf16_t*)(F.ws + WS_H2);
    LAYER0(GRP_A, H2);
    LAYER0(GRP_B, H);
    for (int rep = 0; rep < REP_W; ++rep)
    RUN(phase_weights(F, args.in[9], 32768, args.in[10]));
    LAYER1(GRP_A, H2);
    LAYER1(GRP_B, H);
#undef LAYER0
#undef LAYER1
#undef GRP_A
#undef GRP_B
#undef RUN
}

#ifndef MK_CUTS
#define MK_CUTS {0, NPHASES}
#endif
extern "C" void kernel_launch(void* const* d_in, const int* in_sizes, int n_in, void* d_out, int out_size, void* d_ws, size_t ws_size, hipStream_t stream) {
    static int grid = 0;
    if (grid == 0) {
        if (n_in != 16 || ws_size < WS_END) { fprintf(stderr, "kernel_launch: need 16 inputs and >= %zu bytes of workspace; got n_in %d, ws %zu\n", (size_t)WS_END, n_in, ws_size); grid = -1; return; }
        int dev = 0, cus = 0, per_cu = 0;
        if (hipGetDevice(&dev) != hipSuccess || hipDeviceGetAttribute(&cus, hipDeviceAttributeMultiprocessorCount, dev) != hipSuccess) { grid = -1; return; }
        if (hipFuncSetAttribute((const void*)mk_fwd, hipFuncAttributeMaxDynamicSharedMemorySize, LDS_BYTES) != hipSuccess) { fprintf(stderr, "kernel_launch: hipFuncSetAttribute failed\n"); grid = -1; return; }
        if (hipOccupancyMaxActiveBlocksPerMultiprocessor(&per_cu, (const void*)mk_fwd, 512, LDS_BYTES) != hipSuccess || per_cu < 1)
            fprintf(stderr, "kernel_launch: note: occupancy query reports %d workgroups per CU\n", per_cu);
        (void)hipGetLastError();
        grid = cus;
    }
    if (grid < 0) return;
    (void)in_sizes; (void)out_size;
    if (hipMemsetAsync((char*)d_ws + WS_CTL, 0, CTL_ZERO_BYTES, stream) != hipSuccess) { fprintf(stderr, "kernel_launch: memset failed\n"); return; }
    Args a{};
    for (int i = 0; i < 16; ++i) a.in[i] = (const float*)d_in[i];
    a.out = (float*)d_out; a.ws = (unsigned char*)d_ws; a.pad = 0;
    const int cuts[] = MK_CUTS; const int ncut = (int)(sizeof(cuts) / sizeof(cuts[0])) - 1;
    for (int li = 0; li < ncut; ++li) {
        a.ph_lo = cuts[li]; a.ph_hi = cuts[li + 1]; a.li = li;
        hipLaunchKernelGGL(mk_fwd, dim3(grid), dim3(512), LDS_BYTES, stream, a);
        const hipError_t le = hipPeekAtLastError();
        if (le != hipSuccess) { fprintf(stderr, "kernel_launch: launch %d failed: %s\n", li, hipGetErrorName(le)); break; }
    }
}
```

```cpp
#include <hip/hip_runtime.h>
#include <cstdio>
#include <cstdint>

#define LAS __attribute__((address_space(3)))
typedef unsigned short bf16_t;
typedef short bf16x8 __attribute__((ext_vector_type(8)));
typedef short s16x4 __attribute__((ext_vector_type(4)));
typedef float f32x4 __attribute__((ext_vector_type(4)));
typedef float f32x2 __attribute__((ext_vector_type(2)));
typedef float f32x16 __attribute__((ext_vector_type(16)));
typedef unsigned u32x4 __attribute__((ext_vector_type(4)));
typedef unsigned u32x2 __attribute__((ext_vector_type(2)));

__device__ __forceinline__ unsigned pkbf(float lo, float hi) {
    typedef __bf16 bf2 __attribute__((ext_vector_type(2)));
    bf2 r = __builtin_convertvector((f32x2){lo, hi}, bf2);
    return __builtin_bit_cast(unsigned, r);
}
__device__ __forceinline__ float bflo(unsigned w) { return __uint_as_float(w << 16); }
__device__ __forceinline__ float bfhi(unsigned w) { return __uint_as_float(w & 0xffff0000u); }
__device__ __forceinline__ float wave_sum(float v) {
#pragma unroll
    for (int o = 1; o < 64; o <<= 1) v += __shfl_xor(v, o);
    return v;
}
#define LDS_WAIT() asm volatile("s_waitcnt lgkmcnt(0)" ::: "memory")
#define VM_WAIT() asm volatile("s_waitcnt vmcnt(0)" ::: "memory")

namespace pg8 {
#define PG8_LAS __attribute__((address_space(3)))
constexpr int BM = 256, BK = 64, HALF = 128, HTB = HALF * BK * 2  , STAGE_BYTES = 8 * HTB, NXCD = 8, WGM = 4;

__host__ __device__ __forceinline__ int lds_byte(int r, int c) { const int st = (r >> 4) * 2 + (c >> 5), rr = r & 15, cc = c & 31, ob = rr * 64 + cc * 2; return st * 1024 + (ob ^ (((ob >> 9) & 1) << 5)); }
__host__ __device__ __forceinline__ void stage_rc(int b, int& R, int& C) { const int st = b / 1024, sb = b % 1024, swz = sb ^ (((sb >> 9) & 1) << 5); R = (st >> 1) * 16 + swz / 64; C = (st & 1) * 32 + (swz % 64) / 2; }
__host__ __device__ __forceinline__ int perm32(int rho) { const int n = rho >> 4, i = rho & 15; return 8 * (i >> 2) + 4 * n + (i & 3); }

struct Unit { int pm, pn, k0, nkt, atom; };
struct Gemm { const bf16_t* A; const bf16_t* Bt; int M, N, K; };

struct StaticOrder {
    int nM, nN, nwg, G, c, kt, full, left, S;
    __host__ __device__ __forceinline__ void init(int M, int N, int K, int G_, int c_, int split) { nM = M / BM; nN = N / BM; nwg = nM * nN; G = G_; c = c_; kt = K / BK; full = nwg / G; left = nwg - full * G; S = 1;
        if (split && left > 0 && 2 * left <= G) { S = 2; while (2 * S * left <= G && (kt / (2 * S)) >= 4 && (kt % (2 * S)) == 0) S *= 2; } }
    __host__ __device__ __forceinline__ void tile_of(int L, Unit& u) const {
        int wgid = L; { const int q = nwg / NXCD, r = nwg % NXCD, xcd = wgid % NXCD, off = wgid / NXCD; wgid = (xcd < r ? xcd * (q + 1) : r * (q + 1) + (xcd - r) * q) + off; }
        const int nig = WGM * nN, gid = wgid / nig, fm = gid * WGM, gsz = (nM - fm) < WGM ? (nM - fm) : WGM;
        u.pm = fm + ((wgid % nig) % gsz); u.pn = (wgid % nig) / gsz; }
    __host__ __device__ __forceinline__ bool next(int i, Unit& u) const {
        const bool tailr = S > 1 && i == full;
        const int lu = tailr ? c / S : 0, ks = tailr ? c - lu * S : 0;
        const long L = tailr ? (long)full * G + lu : (long)i * G + c;
        if (tailr ? (c >= left * S) : (L >= nwg)) return false;
        const int nk = tailr ? kt / S : kt;
        tile_of((int)L, u); u.k0 = ks * nk; u.nkt = nk; u.atom = tailr ? 1 : 0; return true;
    }
    __host__ __device__ __forceinline__ int n_tail() const { return S > 1 ? left : 0; }
    __host__ __device__ __forceinline__ void tail_tile(int j, Unit& u) const { tile_of(full * G + j, u); }
    __device__ __forceinline__ void a_ready(const Unit&) const {}
    __device__ __forceinline__ void done(const Unit&) const {}
};

struct EpiM {
    static constexpr bool PERM = true, AFTER_DRAIN = false;
    bf16_t* C; int ldc; float* P;
    __device__ __forceinline__ void operator()(const f32x4 (&acc)[2][2][4][2], const Unit& u, int wr, int wc, int fr, int fq) const {
        if (!u.atom) {
            const int row0 = u.pm * BM + wr * 64 + fr, col0 = u.pn * BM + wc * 32 + 8 * fq;
#pragma unroll
            for (int ai = 0; ai < 2; ++ai)
#pragma unroll
                for (int m = 0; m < 4; ++m) { bf16_t* rowp = C + (size_t)(row0 + ai * HALF + m * 16) * ldc + col0;
#pragma unroll
                    for (int bj = 0; bj < 2; ++bj) { const f32x4 v0 = acc[ai][bj][m][0], v1 = acc[ai][bj][m][1];
                        u32x4 w; w.x = pkbf(v0[0], v0[1]); w.y = pkbf(v0[2], v0[3]); w.z = pkbf(v1[0], v1[1]); w.w = pkbf(v1[2], v1[3]);
                        *(u32x4*)(rowp + bj * HALF) = w; } }
        } else {
            int toff = (wr * 64 + fr) * 256 + wc * 32 + 8 * fq; asm volatile("" : "+v"(toff));
            float* T = P + (size_t)blockIdx.x * 65536 + toff;
#pragma unroll
            for (int ai = 0; ai < 2; ++ai)
#pragma unroll
                for (int m = 0; m < 4; ++m) { float* rowp = T + (ai * HALF + m * 16) * 256;
#pragma unroll
                    for (int bj = 0; bj < 2; ++bj) { *(f32x4*)(rowp + bj * HALF) = acc[ai][bj][m][0]; *(f32x4*)(rowp + bj * HALF + 4) = acc[ai][bj][m][1]; } }
        }
    }
};
struct EpiProj {
    static constexpr bool PERM = true, AFTER_DRAIN = false;
    bf16_t* baseA; size_t strideA; int ldA, shA, cA; bf16_t* baseB; size_t strideB; int ldB, shB;
    __device__ __forceinline__ void operator()(const f32x4 (&acc)[2][2][4][2], const Unit& u, int wr, int wc, int fr, int fq) const {
        const int row0 = u.pm * BM + wr * 64 + fr; const int colt = u.pn * BM;
        const bool inA = colt < cA; const int cc = inA ? colt : colt - cA; const int sh = inA ? shA : shB; const int t = cc >> sh;
        bf16_t* base = (inA ? baseA : baseB) + (size_t)t * (inA ? strideA : strideB);
        const int ldc = inA ? ldA : ldB;
        const int col0 = cc - (t << sh) + wc * 32 + 8 * fq;
#pragma unroll
        for (int ai = 0; ai < 2; ++ai)
#pragma unroll
            for (int m = 0; m < 4; ++m) { bf16_t* rowp = base + (size_t)(row0 + ai * HALF + m * 16) * ldc + col0;
#pragma unroll
                for (int bj = 0; bj < 2; ++bj) { const f32x4 v0 = acc[ai][bj][m][0], v1 = acc[ai][bj][m][1];
                    u32x4 w; w.x = pkbf(v0[0], v0[1]); w.y = pkbf(v0[2], v0[3]); w.z = pkbf(v1[0], v1[1]); w.w = pkbf(v1[2], v1[3]);
                    *(u32x4*)(rowp + bj * HALF) = w; } }
    }
};
template <int LAYER> struct EpiProjRope {
    static constexpr bool PERM = true, AFTER_DRAIN = false;
    EpiProj P; const bf16_t* ctab; const bf16_t* stab; int LP;
    __device__ __forceinline__ void operator()(const f32x4 (&acc)[2][2][4][2], const Unit& u, int wr, int wc, int fr, int fq) const {
        const int colt = u.pn * BM;
        const bool rot = LAYER == 0 ? (colt < 8192) : (colt < 16384 && wc == 0);
        if (!rot) { P(acc, u, wr, wc, fr, fq); return; }
        const int row0 = u.pm * BM + wr * 64 + fr;
        const int pos0 = row0 - (row0 / LP) * LP;
        if (LAYER == 0) {
            const int t = colt >> 12; bf16_t* base = P.baseA + (size_t)t * P.strideA; const float sc = t == 0 ? 0.0625f : 1.0f;
            const int d0 = wc * 32 + 8 * fq, col0 = colt - (t << 12) + d0;
            u32x4 cwa[8], swa[8];
#pragma unroll
            for (int ai = 0; ai < 2; ++ai)
#pragma unroll
                for (int m = 0; m < 4; ++m) { int pos = pos0 + ai * HALF + m * 16; pos = pos >= LP ? pos - LP : pos;
                    cwa[ai * 4 + m] = *(const u32x4*)(ctab + pos * 128 + d0); swa[ai * 4 + m] = *(const u32x4*)(stab + pos * 128 + d0); }
#pragma unroll
            for (int ai = 0; ai < 2; ++ai)
#pragma unroll
                for (int m = 0; m < 4; ++m) {
                    const u32x4 cw = cwa[ai * 4 + m], sw = swa[ai * 4 + m];
                    const f32x4 c0 = (f32x4){bflo(cw.x), bfhi(cw.x), bflo(cw.y), bfhi(cw.y)}, c1 = (f32x4){bflo(cw.z), bfhi(cw.z), bflo(cw.w), bfhi(cw.w)}, s0 = (f32x4){bflo(sw.x), bfhi(sw.x), bflo(sw.y), bfhi(sw.y)}, s1 = (f32x4){bflo(sw.z), bfhi(sw.z), bflo(sw.w), bfhi(sw.w)};
                    const f32x4 a0 = acc[ai][0][m][0], a1 = acc[ai][0][m][1], b0 = acc[ai][1][m][0], b1 = acc[ai][1][m][1];
                    const f32x4 x0 = (a0 * c0 - b0 * s0) * sc, x1 = (a1 * c1 - b1 * s1) * sc, y0 = (b0 * c0 + a0 * s0) * sc, y1 = (b1 * c1 + a1 * s1) * sc;
                    bf16_t* rowp = base + (size_t)(row0 + ai * HALF + m * 16) * 4096 + col0;
                    u32x4 w; w.x = pkbf(x0[0], x0[1]); w.y = pkbf(x0[2], x0[3]); w.z = pkbf(x1[0], x1[1]); w.w = pkbf(x1[2], x1[3]); *(u32x4*)rowp = w;
                    w.x = pkbf(y0[0], y0[1]); w.y = pkbf(y0[2], y0[3]); w.z = pkbf(y1[0], y1[1]); w.w = pkbf(y1[2], y1[3]); *(u32x4*)(rowp + HALF) = w;
                }
        } else {
            const int t = colt >> 13; bf16_t* base = P.baseB + (size_t)t * P.strideB;
            const int col0 = colt - (t << 13) + 8 * fq;
            const bool lo = fq < 2; const int i0 = 8 * (fq & 1);
            u32x4 cwa[8], swa[8];
#pragma unroll
            for (int ai = 0; ai < 2; ++ai)
#pragma unroll
                for (int m = 0; m < 4; ++m) { int pos = pos0 + ai * HALF + m * 16; pos = pos >= LP ? pos - LP : pos;
                    cwa[ai * 4 + m] = *(const u32x4*)(ctab + pos * 16 + i0); swa[ai * 4 + m] = *(const u32x4*)(stab + pos * 16 + i0); }
#pragma unroll
            for (int ai = 0; ai < 2; ++ai)
#pragma unroll
                for (int m = 0; m < 4; ++m) {
                    const u32x4 cw = cwa[ai * 4 + m], sw = swa[ai * 4 + m];
                    const f32x4 c0 = (f32x4){bflo(cw.x), bfhi(cw.x), bflo(cw.y), bfhi(cw.y)}, c1 = (f32x4){bflo(cw.z), bfhi(cw.z), bflo(cw.w), bfhi(cw.w)}, s0 = (f32x4){bflo(sw.x), bfhi(sw.x), bflo(sw.y), bfhi(sw.y)}, s1 = (f32x4){bflo(sw.z), bfhi(sw.z), bflo(sw.w), bfhi(sw.w)};
                    bf16_t* rowp = base + (size_t)(row0 + ai * HALF + m * 16) * 8192 + col0;
#pragma unroll
                    for (int bj = 0; bj < 2; ++bj) {
                        f32x4 v[2] = {acc[ai][bj][m][0], acc[ai][bj][m][1]}, o[2];
#pragma unroll
                        for (int n = 0; n < 2; ++n)
#pragma unroll
                            for (int j = 0; j < 4; ++j) {
                                const unsigned own = __float_as_uint(v[n][j]);
                                auto rr = __builtin_amdgcn_permlane32_swap(own, own, false, false);
                                const float pv = __uint_as_float(lo ? rr[1] : rr[0]);
                                const float c = n == 0 ? c0[j] : c1[j], s = n == 0 ? s0[j] : s1[j];
                                o[n][j] = lo ? v[n][j] * c - pv * s : v[n][j] * c + pv * s;
                            }
                        u32x4 w; w.x = pkbf(o[0][0], o[0][1]); w.y = pkbf(o[0][2], o[0][3]); w.z = pkbf(o[1][0], o[1][1]); w.w = pkbf(o[1][2], o[1][3]);
                        *(u32x4*)(rowp + bj * HALF) = w;
                    }
                }
        }
    }
};
template <class Epi, class Sched>
__device__ __forceinline__ void gemm_phase(PG8_LAS unsigned char* lds, const Gemm g, const Sched& S, const Epi& E, const int tid) {
    const int wid = __builtin_amdgcn_readfirstlane(tid >> 6), lane = tid & 63, wr = wid >> 2, wc = wid & 3, fr = lane & 15, fq = lane >> 4;
    const int K = g.K;
    unsigned voffA[2], voffB[2];
#pragma unroll
    for (int i = 0; i < 2; ++i) { int R, C; stage_rc(tid * 16 + i * 8192, R, C); const int Rb = Epi::PERM ? ((R & ~31) + perm32(R & 31)) : R;
        voffA[i] = (unsigned)(R * K + C) * 2u; voffB[i] = (unsigned)(Rb * K + C) * 2u; }
    const size_t kstep = (size_t)(BK * 2);
    const size_t hstep = (size_t)HALF * K * 2;
    const size_t tstep = 2 * hstep;
    const unsigned ldsw = (unsigned)wid * 1024u;
    const int aoff = lds_byte(wr * 64 + fr, fq * 8), boff = lds_byte(wc * 32 + fr, fq * 8);
#define PG8_SA(b, h) (((b) * 2 + (h)) * HTB)
#define PG8_SB(b, h) ((4 + (b) * 2 + (h)) * HTB)
#define PG8_STAGE(bufoff, gbase, voff) do { _Pragma("unroll") for (int _i = 0; _i < 2; ++_i) \
        __builtin_amdgcn_global_load_lds((const unsigned*)((const char*)(gbase) + (voff)[_i]), (PG8_LAS unsigned*)(lds + (bufoff) + ldsw + _i * 8192), 16, 0, 0); } while (0)
#define PG8_LDA(dst, b, h) do { _Pragma("unroll") for (int m = 0; m < 4; ++m) _Pragma("unroll") for (int k = 0; k < 2; ++k) dst[m][k] = *(const PG8_LAS bf16x8*)(lds + PG8_SA(b, h) + aoff + m * 2048 + k * 1024); } while (0)
#define PG8_LDB(dst, b, h) do { _Pragma("unroll") for (int n = 0; n < 2; ++n) _Pragma("unroll") for (int k = 0; k < 2; ++k) dst[n][k] = *(const PG8_LAS bf16x8*)(lds + PG8_SB(b, h) + boff + n * 2048 + k * 1024); } while (0)
#define PG8_MMA(ai, bj, At, Bt) do { __builtin_amdgcn_s_setprio(1); _Pragma("unroll") for (int m = 0; m < 4; ++m) _Pragma("unroll") for (int n = 0; n < 2; ++n) _Pragma("unroll") for (int k = 0; k < 2; ++k) \
        acc[ai][bj][m][n] = __builtin_amdgcn_mfma_f32_16x16x32_bf16(Bt[n][k], At[m][k], acc[ai][bj][m][n], 0, 0, 0); __builtin_amdgcn_s_setprio(0); } while (0)
#define PG8_WAIT_V(n) asm volatile("s_waitcnt vmcnt(" #n ")" ::: "memory")
#define PG8_WAIT_L(n) asm volatile("s_waitcnt lgkmcnt(" #n ")" ::: "memory")
#define PG8_BAR __builtin_amdgcn_s_barrier()
#define PG8_SCHED __builtin_amdgcn_sched_barrier(0)
    Unit cur, nxt; int ui = 0;
    if (!S.next(0, cur)) return;
    f32x4 acc[2][2][4][2];
#pragma unroll
    for (int a = 0; a < 2; ++a)
#pragma unroll
        for (int b = 0; b < 2; ++b)
#pragma unroll
            for (int m = 0; m < 4; ++m)
#pragma unroll
                for (int n = 0; n < 2; ++n) acc[a][b][m][n] = (f32x4){0.f, 0.f, 0.f, 0.f};
    bf16x8 At[4][2], B0[2][2], B1[2][2];
    const char* cA = (const char*)g.A + (size_t)cur.pm * tstep + (size_t)cur.k0 * kstep; const char* cB = (const char*)g.Bt + (size_t)cur.pn * tstep + (size_t)cur.k0 * kstep;
    S.a_ready(cur);
    PG8_STAGE(PG8_SB(0, 0), cB, voffB); PG8_STAGE(PG8_SA(0, 0), cA, voffA); PG8_STAGE(PG8_SB(0, 1), cB + hstep, voffB); PG8_STAGE(PG8_SA(0, 1), cA + hstep, voffA);
    if (wr == 1) PG8_BAR;
    PG8_WAIT_V(4); PG8_BAR;
    PG8_STAGE(PG8_SB(1, 0), cB + kstep, voffB); PG8_STAGE(PG8_SA(1, 0), cA + kstep, voffA); PG8_STAGE(PG8_SB(1, 1), cB + hstep + kstep, voffB);
    PG8_WAIT_V(6); PG8_BAR;
    for (;;) {
        const bool has_next = S.next(ui + 1, nxt);
        const char* nA = has_next ? (const char*)g.A + (size_t)nxt.pm * tstep + (size_t)nxt.k0 * kstep : cA; const char* nB = has_next ? (const char*)g.Bt + (size_t)nxt.pn * tstep + (size_t)nxt.k0 * kstep : cB;
        const int nt = cur.nkt;
        for (int t = 0; t < nt; t += 2) {
            const bool last = (t == nt - 2);
            const char* a1 = cA + (size_t)(t + 1) * kstep;
            const char* a2 = last ? nA : cA + (size_t)(t + 2) * kstep; const char* b2 = last ? nB : cB + (size_t)(t + 2) * kstep;
            const char* a3 = a2 + kstep; const char* b3 = b2 + kstep;
            if (last && has_next) S.a_ready(nxt);
            PG8_LDB(B0, 0, 0); PG8_SCHED; PG8_LDA(At, 0, 0); PG8_STAGE(PG8_SA(1, 1), a1 + hstep, voffA);
            PG8_WAIT_L(8); PG8_BAR; PG8_WAIT_L(0); PG8_MMA(0, 0, At, B0); PG8_BAR; PG8_SCHED;
            PG8_LDB(B1, 0, 1); PG8_STAGE(PG8_SB(0, 0), b2, voffB);
            PG8_BAR; PG8_WAIT_L(0); PG8_MMA(0, 1, At, B1); PG8_BAR;
            PG8_LDA(At, 0, 1); PG8_STAGE(PG8_SA(0, 0), a2, voffA);
            PG8_BAR; PG8_WAIT_L(0); PG8_MMA(1, 0, At, B0); PG8_BAR; PG8_SCHED;
            PG8_STAGE(PG8_SB(0, 1), b2 + hstep, voffB);
            PG8_WAIT_V(6); PG8_BAR; PG8_MMA(1, 1, At, B1); PG8_BAR;
            PG8_LDB(B0, 1, 0); PG8_SCHED; PG8_LDA(At, 1, 0); PG8_STAGE(PG8_SA(0, 1), a2 + hstep, voffA);
            PG8_WAIT_L(8); PG8_BAR; PG8_WAIT_L(0); PG8_MMA(0, 0, At, B0); PG8_BAR; PG8_SCHED;
            PG8_LDB(B1, 1, 1); PG8_STAGE(PG8_SB(1, 0), b3, voffB);
            PG8_BAR; PG8_WAIT_L(0); PG8_MMA(0, 1, At, B1); PG8_BAR;
            PG8_LDA(At, 1, 1); PG8_STAGE(PG8_SA(1, 0), a3, voffA);
            PG8_BAR; PG8_WAIT_L(0); PG8_MMA(1, 0, At, B0); PG8_BAR; PG8_SCHED;
            PG8_STAGE(PG8_SB(1, 1), b3 + hstep, voffB);
            PG8_WAIT_V(6); PG8_BAR; PG8_MMA(1, 1, At, B1); PG8_BAR;
        }
        if constexpr (!Epi::AFTER_DRAIN) { E(acc, cur, wr, wc, fr, fq); S.done(cur); }
        if (!has_next) break;
#pragma unroll
        for (int a = 0; a < 2; ++a)
#pragma unroll
            for (int b = 0; b < 2; ++b)
#pragma unroll
                for (int m = 0; m < 4; ++m)
#pragma unroll
                    for (int n = 0; n < 2; ++n) acc[a][b][m][n] = (f32x4){0.f, 0.f, 0.f, 0.f};
        cur = nxt; cA = nA; cB = nB; ++ui;
    }
    PG8_WAIT_V(0);
    if (wr == 0) PG8_BAR;
    PG8_BAR;
    if constexpr (Epi::AFTER_DRAIN) { E.fused(acc, cur, wr, wc, fr, fq, lds, wid, lane); S.done(cur); }
#undef PG8_SA
#undef PG8_SB
#undef PG8_STAGE
#undef PG8_LDA
#undef PG8_LDB
#undef PG8_MMA
#undef PG8_WAIT_V
#undef PG8_WAIT_L
#undef PG8_BAR
#undef PG8_SCHED
}
}

namespace att {
constexpr int D = 128, NW = 8, QBLK = 32, KVBLK = 64;
constexpr float SCALE = 0.088388347648318440f;
constexpr float THR = 8.f;
#ifndef ATT_SDEPTH
#define ATT_SDEPTH 1
#endif
constexpr int SDEPTH = ATT_SDEPTH;
constexpr int LD = 8192;
constexpr size_t SHM_V = KVBLK * D * 2, SHM_K = KVBLK * D * 2, SHM_ATTN = 2 * SHM_V + 2 * SHM_K + NW * 64 * 4;
#define KSWZ(row, colB) ((row) * 256 + ((colB) ^ (((row) & 7) << 4)))
#define SBAR() __builtin_amdgcn_sched_barrier(0)
__device__ __forceinline__ int crow(int r, int hi) { return (r & 3) + 8 * (r >> 2) + 4 * hi; }
__device__ __forceinline__ unsigned cvtpk(float lo, float hi) {
  unsigned r; asm volatile("v_cvt_pk_bf16_f32 %0, %1, %2" : "=v"(r) : "v"(lo), "v"(hi)); return r;
}
__device__ __forceinline__ void partialSM(f32x16& p0, f32x16& p1, float& m_reg, float& mn, float& alpha) {
  constexpr float C = SCALE * 1.4426950408889634f;
  float pmax = p0[0]; for (int r = 1; r < 16; ++r) pmax = fmaxf(pmax, p0[r]); for (int r = 0; r < 16; ++r) pmax = fmaxf(pmax, p1[r]);
  { auto rr = __builtin_amdgcn_permlane32_swap(__float_as_uint(pmax), __float_as_uint(pmax), false, false);
    pmax = fmaxf(__uint_as_float(rr[0]), __uint_as_float(rr[1])); }
  if (__builtin_expect(__all(pmax - m_reg <= THR / SCALE), 1)) { mn = m_reg; alpha = 1.f; }
  else { mn = fmaxf(m_reg, pmax); alpha = __builtin_amdgcn_exp2f((m_reg - mn) * C); m_reg = mn; }
  float mnC = -mn * C;
  for (int r = 0; r < 16; ++r) p0[r] = fmaf(p0[r], C, mnC); for (int r = 0; r < 16; ++r) p1[r] = fmaf(p1[r], C, mnC);
  for (int r = 0; r < 16; ++r) p0[r] = __builtin_amdgcn_exp2f(p0[r]);
}
__device__ __forceinline__ void finishSM(f32x16& p0, f32x16& p1, float alpha, float& l_reg, bf16x8& pa0, bf16x8& pa1, bf16x8& pa2, bf16x8& pa3) {
  for (int r = 0; r < 16; ++r) p1[r] = __builtin_amdgcn_exp2f(p1[r]);
  float ps = 0; for (int r = 0; r < 16; ++r) ps += p0[r]; for (int r = 0; r < 16; ++r) ps += p1[r];
  { auto rr = __builtin_amdgcn_permlane32_swap(__float_as_uint(ps), __float_as_uint(ps), false, false);
    ps = __uint_as_float(rr[0]) + __uint_as_float(rr[1]); }
  l_reg = l_reg * alpha + ps;
#define PK4(P, BASE, OUT) do { unsigned a0 = cvtpk(P[BASE + 0], P[BASE + 1]), a1 = cvtpk(P[BASE + 2], P[BASE + 3]);   \
    unsigned b0 = cvtpk(P[BASE + 4], P[BASE + 5]), b1 = cvtpk(P[BASE + 6], P[BASE + 7]);                              \
    auto r0 = __builtin_amdgcn_permlane32_swap(a0, b0, false, false); auto r1 = __builtin_amdgcn_permlane32_swap(a1, b1, false, false); \
    u32x4 w = {r0[0], r1[0], r0[1], r1[1]}; OUT = *reinterpret_cast<bf16x8*>(&w); } while (0)
  PK4(p0, 0, pa0); PK4(p0, 8, pa1); PK4(p1, 0, pa2); PK4(p1, 8, pa3);
#undef PK4
}
__device__ __forceinline__ void qkt(f32x16& p0, f32x16& p1, const bf16_t* Ks, const bf16x8* qr, int r32, int hi) {
  p0 = f32x16{}; p1 = f32x16{};
  for (int d0 = 0; d0 < 8; ++d0) { int cb = (d0 * 16 + hi * 8) * 2;
    bf16x8 b0 = *reinterpret_cast<const bf16x8*>((const char*)Ks + KSWZ(r32, cb));
    bf16x8 b1 = *reinterpret_cast<const bf16x8*>((const char*)Ks + KSWZ(32 + r32, cb));
    p0 = __builtin_amdgcn_mfma_f32_32x32x16_bf16(b0, qr[d0], p0, 0, 0, 0);
    p1 = __builtin_amdgcn_mfma_f32_32x32x16_bf16(b1, qr[d0], p1, 0, 0, 0); }
}
__device__ __forceinline__ int v_st(int k, int c) { const int kk = (k & ~0xC) | ((k & 4) << 1) | ((k & 8) >> 1); return ((kk >> 3) * 4 + (c >> 5)) * 512 + ((kk & 7) * 32 + (c & 31)) * 2; }
__device__ __forceinline__ int v_rd_base(int lane) { return ((lane & 3) << 3) | (((lane >> 2) & 3) << 6) | (((lane >> 4) & 1) << 5) | (((lane >> 5) & 1) << 8); }
constexpr int v_rd_off(int d0, int ks, int half) { return d0 * 512 + ks * 4096 + half * 2048; }
template <int OFF> __device__ __forceinline__ s16x4 tr_read(int vb) {
  s16x4 r; asm volatile("ds_read_b64_tr_b16 %0, %1 offset:%2" : "=&v"(r) : "v"(vb), "i"(OFF) : "memory"); return r;
}
template <int D0> __device__ __forceinline__ void pv_one(f32x16& od, int vb, bf16x8 pa0, bf16x8 pa1, bf16x8 pa2, bf16x8 pa3) {
  const s16x4 l0 = tr_read<v_rd_off(D0, 0, 0)>(vb), h0 = tr_read<v_rd_off(D0, 0, 1)>(vb), l1 = tr_read<v_rd_off(D0, 1, 0)>(vb), h1 = tr_read<v_rd_off(D0, 1, 1)>(vb);
  const s16x4 l2 = tr_read<v_rd_off(D0, 2, 0)>(vb), h2 = tr_read<v_rd_off(D0, 2, 1)>(vb), l3 = tr_read<v_rd_off(D0, 3, 0)>(vb), h3 = tr_read<v_rd_off(D0, 3, 1)>(vb);
  asm volatile("s_waitcnt lgkmcnt(0)" ::: "memory"); SBAR();
#define PK(L, H) (bf16x8){L[0], L[1], L[2], L[3], H[0], H[1], H[2], H[3]}
  od = __builtin_amdgcn_mfma_f32_32x32x16_bf16(pa0, PK(l0, h0), od, 0, 0, 0);
  od = __builtin_amdgcn_mfma_f32_32x32x16_bf16(pa1, PK(l1, h1), od, 0, 0, 0);
  od = __builtin_amdgcn_mfma_f32_32x32x16_bf16(pa2, PK(l2, h2), od, 0, 0, 0);
  od = __builtin_amdgcn_mfma_f32_32x32x16_bf16(pa3, PK(l3, h3), od, 0, 0, 0);
#undef PK
}
__device__ __forceinline__ void pv_d0(f32x16* o, int vb, bf16x8 pa0, bf16x8 pa1, bf16x8 pa2, bf16x8 pa3) {
  pv_one<0>(o[0], vb, pa0, pa1, pa2, pa3); pv_one<1>(o[1], vb, pa0, pa1, pa2, pa3); pv_one<2>(o[2], vb, pa0, pa1, pa2, pa3); pv_one<3>(o[3], vb, pa0, pa1, pa2, pa3);
}

}

constexpr int DM = 4096, NMETA = 16;
constexpr int NSEQ_A = 8, L_A = 2064, LP_A = 2112, TP_A = NSEQ_A * LP_A;
constexpr int NSEQ_B = 2, L_B = 8208, LP_B = 8320, TP_B = NSEQ_B * LP_B;
constexpr int TPMAX = TP_A, LPMAX = LP_B;
constexpr float NORM_EPS = 1e-6f;
constexpr float LAMBDA_INIT = 0.35550906f;
static_assert(TP_A % 256 == 0 && TP_B % 256 == 0 && LP_A % 64 == 0 && LP_B % 64 == 0, "padding");

constexpr size_t MiB = 1u << 20;
constexpr size_t WS_CTL = 0, CTL_ZERO_BYTES = 1 * MiB;
constexpr size_t WS_COSR = 1 * MiB;
constexpr size_t WS_SINR = WS_COSR + (size_t)LPMAX * 128 * 4;
constexpr size_t WS_COSD = WS_SINR + (size_t)LPMAX * 128 * 4;
constexpr size_t WS_SIND = WS_COSD + (size_t)LPMAX * 16 * 4;
constexpr size_t WS_XM = 12 * MiB;
constexpr size_t WS_W = 16 * MiB;
constexpr size_t WS_H = 336 * MiB;
constexpr size_t WS_R = 472 * MiB, RS = (size_t)TPMAX * 8192 * 2;
constexpr size_t WS_H2 = WS_R + 5 * RS;
constexpr size_t WS_END = WS_H2 + (size_t)TPMAX * 4096 * 2;
static_assert(WS_SIND + (size_t)LPMAX * 16 * 4 <= WS_XM && WS_XM + 10 * 16 * 4096 * 4 <= WS_W && WS_W + 320 * MiB <= WS_H && WS_H + (size_t)TPMAX * 4096 * 2 <= WS_R, "ws map");
constexpr int CW_BAR = 4096;
constexpr int MAX_LAUNCHES = 48;

#define XB_TMO      128
#define XB_XCNT(j)  (256  + 64 * (j))
#define XB_XSUB(j)  (1280 + 64 * (j))
#define XB_XGEN(j)  (2304 + 64 * (j))
#define XB_TOP      3328
#define XB_TOPGEN   3392
#define XCD_BAR_WORDS 3456
#define XB_SPIN_CAP (1u << 18)
static_assert((CW_BAR + MAX_LAUNCHES * XCD_BAR_WORDS) * 4 <= (int)CTL_ZERO_BYTES, "barrier regions inside the memset");
__device__ __forceinline__ unsigned xb_ld(unsigned* p)              { return __hip_atomic_load(p, __ATOMIC_RELAXED, __HIP_MEMORY_SCOPE_AGENT); }
__device__ __forceinline__ unsigned xb_add(unsigned* p, unsigned v) { return __hip_atomic_fetch_add(p, v, __ATOMIC_RELAXED, __HIP_MEMORY_SCOPE_AGENT); }
__device__ __forceinline__ unsigned xb_xcc_id() { return (unsigned)__builtin_amdgcn_s_getreg((3 << 11) | 20) & 0xFu; }
#define XB_SPIN(cond, bar) do { unsigned _sp = 0; while (cond) { __builtin_amdgcn_s_sleep(1); \
    if ((++_sp & 255u) == 0u) { if (xb_ld(&(bar)[XB_TMO])) break; if (_sp > XB_SPIN_CAP) { atomicAdd(&(bar)[XB_TMO], 1u); break; } } } } while (0)
struct XcdBarrier { unsigned* bar; unsigned x; volatile LAS unsigned* st; int wave; };
__device__ __forceinline__ int lane_id_now() { int l; asm volatile("v_mbcnt_lo_u32_b32 %0, -1, 0\n\tv_mbcnt_hi_u32_b32 %0, -1, %0" : "=v"(l)); return l; }
__device__ __forceinline__ bool xb_thread0(int wave) { return wave == 0 && lane_id_now() == 0; }
__device__ __forceinline__ XcdBarrier xcd_barrier_post(unsigned* bar, volatile LAS unsigned* st, int wave) {
    XcdBarrier b; b.bar = bar; b.x = xb_xcc_id(); b.st = st; b.wave = wave;
    if (xb_thread0(wave)) (void)xb_add(&bar[XB_XCNT(b.x)], 1u);
    return b;
}
__device__ __forceinline__ void xcd_barrier_complete(unsigned* bar, unsigned x, unsigned& nloc, unsigned& nx) {
    const unsigned G = gridDim.x * gridDim.y * gridDim.z;
    unsigned sum, cnt, mine, sp = 0u;
    for (;;) {
        sum = 0u; cnt = 0u; mine = 0u;
#pragma unroll
        for (unsigned j = 0; j < 16; ++j) { const unsigned c = xb_ld(&bar[XB_XCNT(j)]); sum += c; cnt += (c > 0u) ? 1u : 0u; mine = (j == x) ? c : mine; }
        if (sum == G) break;
        __builtin_amdgcn_s_sleep(1);
        if ((++sp & 255u) == 0u) { if (xb_ld(&bar[XB_TMO])) break; if (sp > XB_SPIN_CAP) { atomicAdd(&bar[XB_TMO], 1u); break; } }
    }
    nloc = mine > 0u ? mine : 1u; nx = cnt > 0u ? cnt : 1u;
}
__device__ __forceinline__ void xcd_barrier(const XcdBarrier& b) {
    asm volatile("s_waitcnt vmcnt(0)" ::: "memory");
    __syncthreads();
    if (xb_thread0(b.wave)) {
        unsigned* bar = b.bar; unsigned bx = b.x; asm volatile("" : "+s"(bx));
        __builtin_amdgcn_s_waitcnt(0);
        unsigned nloc = b.st[0], nx = b.st[1];
        if (nloc == 0u) { xcd_barrier_complete(bar, bx, nloc, nx); b.st[0] = nloc; b.st[1] = nx; }
        const unsigned old = xb_add(&bar[XB_XSUB(bx)], 1u);
        const unsigned gen = old / nloc;
        if (old + 1u == (gen + 1u) * nloc) {
            __builtin_amdgcn_fence(__ATOMIC_RELEASE, "agent");
            asm volatile("s_waitcnt vmcnt(0)" ::: "memory");
            const unsigned og = xb_add(&bar[XB_TOP], 1u);
            const unsigned tg = og / nx;
            if (og + 1u == (tg + 1u) * nx) xb_add(&bar[XB_TOPGEN], 1u);
            else XB_SPIN(xb_ld(&bar[XB_TOPGEN]) == tg, bar);
            __builtin_amdgcn_fence(__ATOMIC_ACQUIRE, "agent");
            xb_add(&bar[XB_XGEN(bx)], 1u);
            asm volatile("s_waitcnt vmcnt(0)" ::: "memory");
        } else {
            XB_SPIN(xb_ld(&bar[XB_XGEN(bx)]) == gen, bar);
            __builtin_amdgcn_fence(__ATOMIC_ACQUIRE, "agent");
            asm volatile("s_waitcnt vmcnt(0)" ::: "memory");
        }
    }
    __syncthreads();
}

__device__ __forceinline__ void xcd_barrier_nc(const XcdBarrier& b) {
    asm volatile("s_waitcnt vmcnt(0)" ::: "memory");
    __syncthreads();
    if (xb_thread0(b.wave)) {
        unsigned* bar = b.bar; unsigned bx = b.x; asm volatile("" : "+s"(bx));
        __builtin_amdgcn_s_waitcnt(0);
        unsigned nloc = b.st[0], nx = b.st[1];
        const unsigned old = xb_add(&bar[XB_XSUB(bx)], 1u);
        const unsigned gen = old / nloc;
        if (old + 1u == (gen + 1u) * nloc) {
            __builtin_amdgcn_fence(__ATOMIC_RELEASE, "agent");
            asm volatile("s_waitcnt vmcnt(0)" ::: "memory");
            const unsigned og = xb_add(&bar[XB_TOP], 1u);
            const unsigned tg = og / nx;
            if (og + 1u == (tg + 1u) * nx) xb_add(&bar[XB_TOPGEN], 1u);
            else XB_SPIN(xb_ld(&bar[XB_TOPGEN]) == tg, bar);
            __builtin_amdgcn_fence(__ATOMIC_ACQUIRE, "agent");
            xb_add(&bar[XB_XGEN(bx)], 1u);
            asm volatile("s_waitcnt vmcnt(0)" ::: "memory");
        } else {
            XB_SPIN(xb_ld(&bar[XB_XGEN(bx)]) == gen, bar);
            __builtin_amdgcn_fence(__ATOMIC_ACQUIRE, "agent");
            asm volatile("s_waitcnt vmcnt(0)" ::: "memory");
        }
    }
    __syncthreads();
}

constexpr int RING_BYTES = 131072;
constexpr int MISC_OFF = RING_BYTES;
constexpr int LDS_BYTES = 151552;

struct Grp { int nseq, L, LP, TP, seq0; const float* x; float* y; };
struct Frame {
    LAS unsigned char* lds; char* ldsg;
    int tid, lane, wave, gw, ngw, G;
    unsigned char* ws;
};

__device__ __forceinline__ void transpose_item(const float* __restrict__ W, int K, int N, bf16_t* __restrict__ WT, LAS float* scr, int item, int lane) {
    const int nblk = N / 32, kb = item / nblk, nb = item % nblk, k0 = 64 * kb, n0 = 32 * nb;
#pragma unroll 8
    for (int i = 0; i < 32; ++i) { const int kk = 2 * i + (lane >> 5); scr[kk * 33 + (lane & 31)] = W[(size_t)(k0 + kk) * N + n0 + (lane & 31)]; }
    LDS_WAIT(); asm volatile("" ::: "memory");
    const int c = lane & 7;
#pragma unroll
    for (int j = 0; j < 4; ++j) { const int n = (lane >> 3) + 8 * j; const LAS float* s = scr + (8 * c) * 33 + n;
        u32x4 o; o.x = pkbf(s[0 * 33], s[1 * 33]); o.y = pkbf(s[2 * 33], s[3 * 33]); o.z = pkbf(s[4 * 33], s[5 * 33]); o.w = pkbf(s[6 * 33], s[7 * 33]);
        *(u32x4*)(WT + (size_t)(n0 + n) * K + k0 + 8 * c) = o; }
    LDS_WAIT(); asm volatile("" ::: "memory");
}
__device__ __forceinline__ void phase_weights(Frame& F, const float* Win, int Nin, const float* Wout) {
    LAS float* scr = (LAS float*)(F.lds + F.wave * 16384);
    bf16_t* WinT = (bf16_t*)(F.ws + WS_W); bf16_t* WoutT = WinT + (size_t)Nin * DM;
    const int I1 = (DM / 64) * (Nin / 32), I2 = (8192 / 64) * (DM / 32);
    for (int it = F.gw; it < I1 + I2; it += F.ngw) {
        if (it < I1) transpose_item(Win, DM, Nin, WinT, scr, it, F.lane);
        else transpose_item(Wout, 8192, DM, WoutT, scr, it - I1, F.lane);
    }
}
__device__ __forceinline__ void sincos_rev(double rev, float& s, float& c) {
    rev -= floor(rev);
    const double k = floor(rev * 4.0 + 0.5);
    const double x = (rev - k * 0.25) * 6.283185307179586476925;
    const double x2 = x * x;
    const double sn = x * (1.0 + x2 * (-1.0 / 6 + x2 * (1.0 / 120 + x2 * (-1.0 / 5040 + x2 * (1.0 / 362880 + x2 * (-1.0 / 39916800))))));
    const double cs = 1.0 + x2 * (-0.5 + x2 * (1.0 / 24 + x2 * (-1.0 / 720 + x2 * (1.0 / 40320 + x2 * (-1.0 / 3628800 + x2 * (1.0 / 479001600))))));
    const int q = ((int)k) & 3;
    const double ss = q == 0 ? sn : q == 1 ? cs : q == 2 ? -sn : -cs;
    const double cc = q == 0 ? cs : q == 1 ? -sn : q == 2 ? -cs : sn;
    s = (float)ss; c = (float)cc;
}
__device__ __forceinline__ void phase_tables(Frame& F) {
    bf16_t* cosr = (bf16_t*)(F.ws + WS_COSR); bf16_t* sinr = (bf16_t*)(F.ws + WS_SINR); bf16_t* cosd = (bf16_t*)(F.ws + WS_COSD); bf16_t* sind = (bf16_t*)(F.ws + WS_SIND);
    const int gt = blockIdx.x * 512 + F.tid, ngt = F.G * 512;
    for (int i = gt; i < LPMAX * 128; i += ngt) { const int pos = i >> 7, fi = i & 127;
        const float inv = __builtin_exp2f(-(float)fi * (2.0f / 256.0f) * 13.287712379549449f);
        const float ang = (float)pos * inv; float s, c; sincos_rev((double)ang * 0.15915494309189533577, s, c); cosr[i] = (bf16_t)(pkbf(c, 0.f) & 0xffffu); sinr[i] = (bf16_t)(pkbf(s, 0.f) & 0xffffu); }
    for (int i = gt; i < LPMAX * 16; i += ngt) { const int pos = i >> 4, fi = i & 15;
        const float inv = __builtin_exp2f(-(float)fi * (2.0f / 32.0f) * 18.931568569324174f);
        const float ang = (float)pos * inv; float s, c; sincos_rev((double)ang * 0.15915494309189533577, s, c); cosd[i] = (bf16_t)(pkbf(c, 0.f) & 0xffffu); sind[i] = (bf16_t)(pkbf(s, 0.f) & 0xffffu); }
}
__device__ __forceinline__ const float* xrow_ptr(Frame& F, const Grp& g, const float* meta, int layer, int b, int pos) {
    if (layer == 0) return pos < NMETA ? meta + (size_t)pos * DM : g.x + ((size_t)b * (g.L - NMETA) + (pos - NMETA)) * DM;
    return pos < NMETA ? (const float*)(F.ws + WS_XM) + ((size_t)(g.seq0 + b) * NMETA + pos) * DM : g.y + ((size_t)b * (g.L - NMETA) + (pos - NMETA)) * DM;
}
__device__ __forceinline__ void phase_norm(Frame& F, const Grp& g, int layer, const float* meta, const float* pre) {
    bf16_t* H = (bf16_t*)(F.ws + WS_H); const f32x4* gain = (const f32x4*)(pre + (size_t)layer * DM);
    for (int row = F.gw; row < g.TP; row += F.ngw) {
        const int b = row / g.LP, pos = row - b * g.LP;
        u32x2* o8 = (u32x2*)(H + (size_t)row * DM) + F.lane;
        if (pos >= g.L) {
#pragma unroll
            for (int j = 0; j < 16; ++j) o8[64 * j] = (u32x2){0u, 0u};
            continue; }
        const f32x4* xr = (const f32x4*)xrow_ptr(F, g, meta, layer, b, pos) + F.lane;
        f32x4 v[16]; float s = 0.f;
#pragma unroll
        for (int j = 0; j < 16; ++j) v[j] = xr[64 * j];
#pragma unroll
        for (int j = 0; j < 16; ++j) { const f32x4 gn = gain[64 * j + F.lane]; s += (v[j].x * v[j].x + v[j].y * v[j].y) + (v[j].z * v[j].z + v[j].w * v[j].w); v[j] = v[j] * gn; }
        const float r = 1.0f / sqrtf(wave_sum(s) * (1.0f / DM) + NORM_EPS);
#pragma unroll
        for (int j = 0; j < 16; ++j) o8[64 * j] = (u32x2){pkbf(v[j].x * r, v[j].y * r), pkbf(v[j].z * r, v[j].w * r)};
    }
}
__device__ __forceinline__ void phase_post(Frame& F, const Grp& g, int layer, const bf16_t* Mbuf, const float* meta, const float* post, bf16_t* Hn, const float* pre) {
    const f32x4* gain = (const f32x4*)(post + (size_t)layer * DM); const f32x4* gain2 = (const f32x4*)(pre + (size_t)DM);
    for (int row = F.gw; row < g.TP; row += F.ngw) {
        const int b = row / g.LP, pos = row - b * g.LP;
        if (pos >= g.L) { if (layer == 0) { u32x2* o8 = (u32x2*)(Hn + (size_t)row * DM) + F.lane;
#pragma unroll
                for (int j = 0; j < 16; ++j) o8[64 * j] = (u32x2){0u, 0u}; }
            continue; }
        if (layer == 1 && pos < NMETA) continue;
        int ln = F.lane; asm volatile("" : "+v"(ln));
        const u32x2* mr = (const u32x2*)(Mbuf + (size_t)row * DM) + ln;
        float* yrow = g.y + ((size_t)b * (g.L - NMETA) + (pos - NMETA)) * DM;
        f32x4 v[16], x[16]; float s = 0.f;
#pragma unroll
        for (int j = 0; j < 16; ++j) { const u32x2 w = mr[64 * j]; v[j] = (f32x4){bflo(w.x), bfhi(w.x), bflo(w.y), bfhi(w.y)}; s += (v[j].x * v[j].x + v[j].y * v[j].y) + (v[j].z * v[j].z + v[j].w * v[j].w); }
        if (layer == 0) { const f32x4* xr = (const f32x4*)xrow_ptr(F, g, meta, 0, b, pos) + ln;
#pragma unroll
            for (int j = 0; j < 16; ++j) x[j] = xr[64 * j]; }
        else { const u32x2* xr = (const u32x2*)yrow + ln;
#pragma unroll
            for (int j = 0; j < 16; ++j) { const u32x2 w = xr[64 * j]; x[j] = (f32x4){bflo(w.x), bfhi(w.x), bflo(w.y), bfhi(w.y)}; } }
        const float r = 1.0f / sqrtf(wave_sum(s) * (1.0f / DM) + NORM_EPS);
        float s2 = 0.f;
#pragma unroll
        for (int j = 0; j < 16; ++j) { const f32x4 gn = gain[64 * j + ln];
            v[j] = (f32x4){x[j].x + v[j].x * r * gn.x, x[j].y + v[j].y * r * gn.y, x[j].z + v[j].z * r * gn.z, x[j].w + v[j].w * r * gn.w};
            s2 += (v[j].x * v[j].x + v[j].y * v[j].y) + (v[j].z * v[j].z + v[j].w * v[j].w); }
        if (layer == 1) asm volatile("s_waitcnt vmcnt(0)" ::: "memory");
        if (layer == 1 || pos < NMETA) {
            f32x4* dst = (layer == 1 ? (f32x4*)yrow : (f32x4*)((float*)(F.ws + WS_XM) + ((size_t)(g.seq0 + b) * NMETA + pos) * DM)) + ln;
#pragma unroll
            for (int j = 0; j < 16; ++j) dst[64 * j] = v[j];
        } else { u32x2* dst = (u32x2*)yrow + ln;
#pragma unroll
            for (int j = 0; j < 16; ++j) dst[64 * j] = (u32x2){pkbf(v[j].x, v[j].y), pkbf(v[j].z, v[j].w)}; }
        if (layer == 0) {
            const float r2 = 1.0f / sqrtf(wave_sum(s2) * (1.0f / DM) + NORM_EPS);
            u32x2* o8 = (u32x2*)(Hn + (size_t)row * DM) + ln;
#pragma unroll
            for (int j = 0; j < 16; ++j) { const f32x4 gn = gain2[64 * j + ln]; o8[64 * j] = (u32x2){pkbf(v[j].x * r2 * gn.x, v[j].y * r2 * gn.y), pkbf(v[j].z * r2 * gn.z, v[j].w * r2 * gn.w)}; }
        }
    }
}
__device__ __forceinline__ float silu_f(float g) { return g * __builtin_amdgcn_rcpf(1.0f + __builtin_amdgcn_exp2f(-g * 1.4426950408889634f)); }
__device__ __forceinline__ void phase_gate0(Frame& F, const Grp& g, bf16_t* OF, const bf16_t* OB, const bf16_t* G0) {
    const int nitems = g.TP * 16;
    for (int it0 = F.gw; it0 < nitems; it0 += 4 * F.ngw) {
        u32x4 a[4], bb[4], gg[4]; size_t off[4]; bool ok[4];
#pragma unroll
        for (int q = 0; q < 4; ++q) { const int it = it0 + q * F.ngw; const int itc = it < nitems ? it : it0;
            const int row = itc >> 4, hh = itc & 15; const int b = row / g.LP, pos = row - b * g.LP; ok[q] = it < nitems && pos < g.L;
            off[q] = (size_t)row * 8192 + hh * 512 + F.lane * 8;
            a[q] = *(const u32x4*)(OF + off[q]); bb[q] = *(const u32x4*)(OB + off[q]); gg[q] = *(const u32x4*)(G0 + off[q]); }
#pragma unroll
        for (int q = 0; q < 4; ++q) {
            float v[8]; float s = 0.f;
#pragma unroll
            for (int w = 0; w < 4; ++w) { v[2 * w] = bflo(a[q][w]) + bflo(bb[q][w]); v[2 * w + 1] = bfhi(a[q][w]) + bfhi(bb[q][w]); s += v[2 * w] * v[2 * w] + v[2 * w + 1] * v[2 * w + 1]; }
            const float r = 1.0f / sqrtf(wave_sum(s) * (1.0f / 512.0f) + NORM_EPS);
            u32x4 o;
#pragma unroll
            for (int w = 0; w < 4; ++w) o[w] = pkbf(v[2 * w] * r * silu_f(bflo(gg[q][w])), v[2 * w + 1] * r * silu_f(bfhi(gg[q][w])));
            if (ok[q]) *(u32x4*)(OF + off[q]) = o;
        }
    }
}


namespace att5 {
using att::crow; using att::partialSM; using att::finishSM; using att::qkt; using att::tr_read; using att::v_rd_base; using att::v_rd_off;
constexpr int LD2 = 8192 * 2;
constexpr int STAGE = 65536, K_IMG = 16384, V_OFF = 32768;
constexpr int SCR_OFF = MISC_OFF + 256;
static_assert(SCR_OFF + 8 * 256 <= LDS_BYTES, "att5 LDS");

#define ATT_TR8(P, D0) do { constexpr int B_ = ((D0) >> 2) * 16384 + ((D0) & 3) * 512; \
    P##l0 = tr_read<B_ + v_rd_off(0, 0, 0)>(vb); P##h0 = tr_read<B_ + v_rd_off(0, 0, 1)>(vb); P##l1 = tr_read<B_ + v_rd_off(0, 1, 0)>(vb); P##h1 = tr_read<B_ + v_rd_off(0, 1, 1)>(vb); \
    P##l2 = tr_read<B_ + v_rd_off(0, 2, 0)>(vb); P##h2 = tr_read<B_ + v_rd_off(0, 2, 1)>(vb); P##l3 = tr_read<B_ + v_rd_off(0, 3, 0)>(vb); P##h3 = tr_read<B_ + v_rd_off(0, 3, 1)>(vb); } while (0)
#define ATT_PK(L, H) (bf16x8){L[0], L[1], L[2], L[3], H[0], H[1], H[2], H[3]}
#define ATT_MM4(od, P) do { od = __builtin_amdgcn_mfma_f32_32x32x16_bf16(pa0, ATT_PK(P##l0, P##h0), od, 0, 0, 0); od = __builtin_amdgcn_mfma_f32_32x32x16_bf16(pa1, ATT_PK(P##l1, P##h1), od, 0, 0, 0); \
    od = __builtin_amdgcn_mfma_f32_32x32x16_bf16(pa2, ATT_PK(P##l2, P##h2), od, 0, 0, 0); od = __builtin_amdgcn_mfma_f32_32x32x16_bf16(pa3, ATT_PK(P##l3, P##h3), od, 0, 0, 0); } while (0)
#define ATT_W8() do { asm volatile("s_waitcnt lgkmcnt(8)" ::: "memory"); SBAR(); } while (0)
__device__ __forceinline__ void pv_pipe(f32x16 (&o)[8], int vb, bf16x8 pa0, bf16x8 pa1, bf16x8 pa2, bf16x8 pa3) {
  s16x4 Al0, Ah0, Al1, Ah1, Al2, Ah2, Al3, Ah3, Bl0, Bh0, Bl1, Bh1, Bl2, Bh2, Bl3, Bh3;
#define ATT_W0() do { asm volatile("s_waitcnt lgkmcnt(0)" ::: "memory"); SBAR(); } while (0)
  ATT_TR8(A, 0); ATT_W0(); ATT_MM4(o[0], A);
  ATT_TR8(B, 1); ATT_W0(); ATT_MM4(o[1], B);
  ATT_TR8(A, 2); ATT_W0(); ATT_MM4(o[2], A);
  ATT_TR8(B, 3); ATT_W0(); ATT_MM4(o[3], B);
  ATT_TR8(A, 4); ATT_W0(); ATT_MM4(o[4], A);
  ATT_TR8(B, 5); ATT_W0(); ATT_MM4(o[5], B);
  ATT_TR8(A, 6); ATT_W0(); ATT_MM4(o[6], A);
  ATT_TR8(B, 7); ATT_W0(); ATT_MM4(o[7], B);
#undef ATT_W0
}

#define ATT_KRD(dst, base, OFF) asm volatile("ds_read_b128 %0, %1 offset:%2" : "=&v"(dst) : "v"(base), "i"(OFF) : "memory")
__device__ __forceinline__ void qkt_pipe(f32x16& p0, f32x16& p1, unsigned ks, const bf16x8 (&qr)[8], int r32, int hi) {
  const unsigned x = r32 & 7, rowb = ks + r32 * 256 + 16u * (hi ^ (x & 1));
  const unsigned k0 = rowb + 32u * (0u ^ (x >> 1)), k1 = rowb + 32u * (1u ^ (x >> 1)), k2 = rowb + 32u * (2u ^ (x >> 1)), k3 = rowb + 32u * (3u ^ (x >> 1));
  bf16x8 a0, a1, b0, b1, c0, c1;
  p0 = f32x16{}; p1 = f32x16{};
  asm volatile("s_waitcnt lgkmcnt(0)" ::: "memory"); SBAR();
  ATT_KRD(a0, k0, 0); ATT_KRD(a1, k0, 8192); ATT_KRD(b0, k1, 0); ATT_KRD(b1, k1, 8192); ATT_KRD(c0, k2, 0); ATT_KRD(c1, k2, 8192);
#define ATT_QK(f0, f1, d0) do { p0 = __builtin_amdgcn_mfma_f32_32x32x16_bf16(f0, qr[d0], p0, 0, 0, 0); p1 = __builtin_amdgcn_mfma_f32_32x32x16_bf16(f1, qr[d0], p1, 0, 0, 0); } while (0)
#define ATT_W(n) do { asm volatile("s_waitcnt lgkmcnt(" #n ")" ::: "memory"); SBAR(); } while (0)
  ATT_W(4); ATT_QK(a0, a1, 0); SBAR(); ATT_KRD(a0, k3, 0);   ATT_KRD(a1, k3, 8192);
  ATT_W(4); ATT_QK(b0, b1, 1); SBAR(); ATT_KRD(b0, k0, 128); ATT_KRD(b1, k0, 8320);
  ATT_W(4); ATT_QK(c0, c1, 2); SBAR(); ATT_KRD(c0, k1, 128); ATT_KRD(c1, k1, 8320);
  ATT_W(4); ATT_QK(a0, a1, 3); SBAR(); ATT_KRD(a0, k2, 128); ATT_KRD(a1, k2, 8320);
  ATT_W(4); ATT_QK(b0, b1, 4); SBAR(); ATT_KRD(b0, k3, 128); ATT_KRD(b1, k3, 8320);
  ATT_W(4); ATT_QK(c0, c1, 5); SBAR();
  ATT_W(2); ATT_QK(a0, a1, 6); SBAR();
  ATT_W(0); ATT_QK(b0, b1, 7); SBAR();
#undef ATT_QK
#undef ATT_W
}
#undef ATT_KRD


#define A5_MFMA(a, b, c) __builtin_amdgcn_mfma_f32_32x32x16_bf16(a, b, c, 0, 0, 0)
#define A5_PIN(x) asm volatile("" : "+v"(x))
#define A5_KRD(dst, base, OFF) asm volatile("ds_read_b128 %0, %1 offset:%2" : "=&v"(dst) : "v"(base), "i"(OFF) : "memory")
#define A5_W(n) do { asm volatile("s_waitcnt lgkmcnt(" #n ")" ::: "memory"); SBAR(); } while (0)
#define A5_KO(i) (((((i) & 7) >> 2) * 128) + (((i) >> 3) * 8192))
#define A5_VO(D0, KS, H) (((D0) >> 2) * 16384 + ((D0) & 3) * 512 + v_rd_off(0, KS, H))
#define A5_VRD4(P, D0, KH) do { P##l0 = tr_read<A5_VO(D0, 2 * (KH), 0)>(vb); P##h0 = tr_read<A5_VO(D0, 2 * (KH), 1)>(vb); P##l1 = tr_read<A5_VO(D0, 2 * (KH) + 1, 0)>(vb); P##h1 = tr_read<A5_VO(D0, 2 * (KH) + 1, 1)>(vb); } while (0)
#define A5_FMA8(P, b) do { P[b] = __builtin_fmaf(P[b], C, nmC); \
    asm volatile("v_fma_f32 %1, %1, %8, %9\n\tv_fma_f32 %2, %2, %8, %9\n\tv_fma_f32 %3, %3, %8, %9\n\tv_fma_f32 %4, %4, %8, %9\n\tv_fma_f32 %5, %5, %8, %9\n\tv_fma_f32 %6, %6, %8, %9\n\tv_fma_f32 %7, %7, %8, %9" \
      : "+v"(P[b]), "+v"(P[b + 1]), "+v"(P[b + 2]), "+v"(P[b + 3]), "+v"(P[b + 4]), "+v"(P[b + 5]), "+v"(P[b + 6]), "+v"(P[b + 7]) : "s"(Cs), "v"(nmC)); } while (0)
#define A5_MAXALL(P) asm volatile("v_max3_f32 %0, %1, %2, %3\n\tv_max3_f32 %0, %0, %4, %5\n\tv_max3_f32 %0, %0, %6, %7\n\tv_max3_f32 %0, %0, %8, %9\n\tv_max3_f32 %0, %0, %10, %11\n\tv_max3_f32 %0, %0, %12, %13\n\tv_max3_f32 %0, %0, %14, %15\n\tv_max_f32 %0, %0, %16" \
      : "=&v"(mx) : "v"(P[0]), "v"(P[1]), "v"(P[2]), "v"(P[3]), "v"(P[4]), "v"(P[5]), "v"(P[6]), "v"(P[7]), "v"(P[8]), "v"(P[9]), "v"(P[10]), "v"(P[11]), "v"(P[12]), "v"(P[13]), "v"(P[14]), "v"(P[15]))
#define A5_DECIDE(P) do { { auto rr_ = __builtin_amdgcn_permlane32_swap(__float_as_uint(mx), __float_as_uint(mx), false, false); mx = __builtin_fmaxf(__uint_as_float(rr_[0]), __uint_as_float(rr_[1])); } \
    if (!__builtin_expect(__all(mx <= att::THR * 1.4426950408889634f) && !first, 1)) {     \
      const float dl_ = first ? mx : __builtin_fmaxf(mx, 0.f); const float al_ = first ? 0.f : __builtin_amdgcn_exp2f(-dl_); nmC -= dl_; l_reg *= al_; \
      _Pragma("unroll") for (int r_ = 0; r_ < 16; ++r_) P[r_] -= dl_; \
      if (hi == 0) al_l[r32] = al_; resc = !first; first = false; } } while (0)
#define A5_RESC() do { if (__builtin_expect(resc, 0)) { asm volatile("s_waitcnt lgkmcnt(0)" ::: "memory"); \
    _Pragma("unroll") for (int d = 0; d < 8; ++d) _Pragma("unroll") for (int r = 0; r < 16; ++r) o[d][r] *= al_l[crow(r, hi)]; resc = false; } } while (0)
#define A5_EXP2(P, k) do { P[2 * (k)] = __builtin_amdgcn_exp2f(P[2 * (k)]); P[2 * (k) + 1] = __builtin_amdgcn_exp2f(P[2 * (k) + 1]); } while (0)
#define A5_SUM(P, k) l_reg += (P[4 * (k)] + P[4 * (k) + 1]) + (P[4 * (k) + 2] + P[4 * (k) + 3])
#define A5_PK4(P, BASE, OUT) do { unsigned a0_ = att::cvtpk(P[BASE + 0], P[BASE + 1]), a1_ = att::cvtpk(P[BASE + 2], P[BASE + 3]); \
    unsigned b0_ = att::cvtpk(P[BASE + 4], P[BASE + 5]), b1_ = att::cvtpk(P[BASE + 6], P[BASE + 7]); \
    auto r0_ = __builtin_amdgcn_permlane32_swap(a0_, b0_, false, false); auto r1_ = __builtin_amdgcn_permlane32_swap(a1_, b1_, false, false); \
    u32x4 w_ = {r0_[0], r1_[0], r0_[1], r1_[1]}; OUT = __builtin_bit_cast(bf16x8, w_); } while (0)
template <int VARIANT>
__device__ __forceinline__ void unit(const bf16_t* __restrict__ Qp, bf16_t* __restrict__ Op, const bf16_t* __restrict__ Gp, const bf16_t* __restrict__ Kt, const bf16_t* __restrict__ Vt, int nt, int nvalid, int npad, float lam, const float* subln,
                                     LAS unsigned char* lds, char* ldsg, const int tid) {
  const int wid = __builtin_amdgcn_readfirstlane(tid >> 6), lane = tid & 63, r32 = lane & 31, hi = lane >> 5, m = wid >> 2, rw = wid & 3;
  float* wscr = (float*)(ldsg + SCR_OFF) + wid * 64; float* li_l = wscr; float* al_l = wscr + 32;
  const int img = (wid >> 1) & 1, isV = wid >> 2, ph8 = (wid & 1) * 8;
  const char* gsrc = isV ? (const char*)Vt : (const char*)Kt;
  const unsigned dst0 = (unsigned)(isV * V_OFF + img * K_IMG + ph8 * 1024);
#define ATT2_DMA(j) do { const char* tb_ = gsrc + (size_t)(j) * (64 * LD2); const unsigned db_ = ((j) & 1) * STAGE + dst0; \
    unsigned ln_ = lane; asm volatile("" : "+v"(ln_)); unsigned src_e, src_o;     \
    if (!isV) { const unsigned r4 = ln_ >> 4, cs = ln_ & 15;     \
      src_e = r4 * LD2 + img * 256 + 16u * (cs ^ (r4 & 7)); src_o = r4 * LD2 + img * 256 + 16u * (cs ^ ((4 + r4) & 7)); } \
    else { const unsigned t = (ln_ & 31) >> 2;                   \
      src_e = (8u * (t >> 2) + (t & 3)) * LD2 + img * 256 + 64u * (ln_ >> 5) + 16u * (ln_ & 3); src_o = src_e + 128u; } \
    _Pragma("unroll") for (int i = 0; i < 8; ++i) { const int pl = ph8 + i; \
      const unsigned uo = isV ? (unsigned)((16 * (pl >> 2) + 4 * ((pl >> 1) & 1)) * LD2) : (unsigned)(4 * pl * LD2); \
      __builtin_amdgcn_global_load_lds((const unsigned*)(tb_ + uo + ((i & 1) ? src_o : src_e)), (LAS unsigned*)(lds + db_ + i * 1024), 16, 0, 0); } } while (0)
#define A5_DMA_SETUP(jsrc, jst) const char* tb_ = gsrc + (size_t)(jsrc) * (64 * LD2); const unsigned db_ = ((jst) & 1) * STAGE + dst0; unsigned src_e, src_o; \
    { unsigned ln_ = lane; asm volatile("" : "+v"(ln_)); \
      if (!isV) { const unsigned r4 = ln_ >> 4, cs = ln_ & 15; src_e = r4 * LD2 + img * 256 + 16u * (cs ^ (r4 & 7)); src_o = r4 * LD2 + img * 256 + 16u * (cs ^ ((4 + r4) & 7)); } \
      else { const unsigned t = (ln_ & 31) >> 2; src_e = (8u * (t >> 2) + (t & 3)) * LD2 + img * 256 + 64u * (ln_ >> 5) + 16u * (ln_ & 3); src_o = src_e + 128u; } }
#define A5_DMAP(i) do { const int pl = ph8 + (i); const unsigned uo = isV ? (unsigned)((16 * (pl >> 2) + 4 * ((pl >> 1) & 1)) * LD2) : (unsigned)(4 * pl * LD2); \
    __builtin_amdgcn_global_load_lds((const unsigned*)(tb_ + uo + (((i) & 1) ? src_o : src_e)), (LAS unsigned*)(lds + db_ + (i) * 1024), 16, 0, 0); } while (0)
  bf16x8 qr[8];
  { const bf16_t* Qw = Qp + (size_t)(rw * 32 + r32) * 8192 + m * 128 + hi * 8;
#pragma unroll
    for (int d0 = 0; d0 < 8; ++d0) qr[d0] = *(const bf16x8*)(Qw + d0 * 16); }
  float nmC = 0.f, l_reg = 0.f; f32x16 o[8]; bool first = true;
#pragma unroll
  for (int d = 0; d < 8; ++d) o[d] = f32x16{};
  const int vbl = v_rd_base(lane) + V_OFF;
  const bool live = rw * 32 < nvalid;
  ATT2_DMA(0);
  for (int j = 0; j < nt; ++j) {
    asm volatile("s_waitcnt vmcnt(0) lgkmcnt(0)" ::: "memory"); __builtin_amdgcn_s_barrier(); asm volatile("" ::: "memory");
    const int jn = (j + 1 < nt) ? j + 1 : j;
    if (!live) { A5_DMA_SETUP(jn, j + 1); A5_DMAP(0); A5_DMAP(1); A5_DMAP(2); A5_DMAP(3); A5_DMAP(4); A5_DMAP(5); A5_DMAP(6); A5_DMAP(7); }
    if (live) {
      constexpr float C = att::SCALE * 1.4426950408889634f; const float Cs = C;
      f32x16 p0 = f32x16{}, p1 = f32x16{}; bf16x8 pa0, pa1, pa2, pa3; float mx; bool resc = false;
        const unsigned ks = (unsigned)((j & 1) * STAGE + m * K_IMG);
        const unsigned x = r32 & 7, rowb = ks + r32 * 256 + 16u * (hi ^ (x & 1));
        const unsigned k0 = rowb + 32u * (0u ^ (x >> 1)), k1 = rowb + 32u * (1u ^ (x >> 1)), k2 = rowb + 32u * (2u ^ (x >> 1)), k3 = rowb + 32u * (3u ^ (x >> 1));
        bf16x8 fa, fb, fc, fd;
        A5_KRD(fa, k0, A5_KO(0)); A5_KRD(fb, k1, A5_KO(1)); A5_KRD(fc, k2, A5_KO(2)); A5_KRD(fd, k3, A5_KO(3)); SBAR();
        A5_DMA_SETUP(jn, j + 1); asm volatile("" : "+v"(src_e), "+v"(src_o)); SBAR();
        A5_W(3); p0 = A5_MFMA(fa, qr[0], p0); A5_DMAP(0); SBAR(); A5_KRD(fa, k0, A5_KO(4));
        A5_W(3); p0 = A5_MFMA(fb, qr[1], p0); SBAR(); A5_KRD(fb, k1, A5_KO(5));
        A5_W(3); p0 = A5_MFMA(fc, qr[2], p0); A5_DMAP(1); SBAR(); A5_KRD(fc, k2, A5_KO(6));
        A5_W(3); p0 = A5_MFMA(fd, qr[3], p0); SBAR(); A5_KRD(fd, k3, A5_KO(7));
        A5_W(3); p0 = A5_MFMA(fa, qr[4], p0); A5_DMAP(2); SBAR(); A5_KRD(fa, k0, A5_KO(8));
        A5_W(3); p0 = A5_MFMA(fb, qr[5], p0); SBAR(); A5_KRD(fb, k1, A5_KO(9));
        A5_W(3); p0 = A5_MFMA(fc, qr[6], p0); SBAR(); A5_KRD(fc, k2, A5_KO(10));
        A5_W(3); p0 = A5_MFMA(fd, qr[7], p0); SBAR(); A5_KRD(fd, k3, A5_KO(11));
        A5_W(3); p1 = A5_MFMA(fa, qr[0], p1); A5_DMAP(3); SBAR();     A5_FMA8(p0, 0); SBAR(); A5_KRD(fa, k0, A5_KO(12));
        A5_W(3); p1 = A5_MFMA(fb, qr[1], p1); A5_FMA8(p0, 8); A5_MAXALL(p0); SBAR(); A5_KRD(fb, k1, A5_KO(13));
        A5_W(3); p1 = A5_MFMA(fc, qr[2], p1); A5_DECIDE(p0); A5_EXP2(p0, 0); A5_EXP2(p0, 1); A5_EXP2(p0, 2); A5_PIN(p0); SBAR(); A5_KRD(fc, k2, A5_KO(14));
        A5_W(3); p1 = A5_MFMA(fd, qr[3], p1); A5_EXP2(p0, 3); A5_EXP2(p0, 4); A5_EXP2(p0, 5); A5_PIN(p0); SBAR(); A5_KRD(fd, k3, A5_KO(15));
        A5_W(3); p1 = A5_MFMA(fa, qr[4], p1); A5_EXP2(p0, 6); A5_EXP2(p0, 7); A5_SUM(p0, 0); A5_PIN(p0); A5_PIN(l_reg); SBAR();
        A5_W(2); p1 = A5_MFMA(fb, qr[5], p1); A5_SUM(p0, 1); A5_PK4(p0, 0, pa0); A5_PIN(pa0); A5_PIN(l_reg); SBAR();
        A5_W(1); p1 = A5_MFMA(fc, qr[6], p1); A5_SUM(p0, 2); A5_SUM(p0, 3); A5_PIN(l_reg); SBAR();
        A5_W(0); p1 = A5_MFMA(fd, qr[7], p1); A5_PK4(p0, 8, pa1); A5_PIN(pa1); SBAR();
      A5_RESC();
      { const int vb = vbl + (j & 1) * STAGE;
        s16x4 Al0, Ah0, Al1, Ah1, Bl0, Bh0, Bl1, Bh1;
        A5_VRD4(A, 0, 0);
        A5_VRD4(B, 1, 0); A5_W(4); o[0] = A5_MFMA(pa0, ATT_PK(Al0, Ah0), o[0]); A5_FMA8(p1, 0); A5_DMAP(4); SBAR();              o[0] = A5_MFMA(pa1, ATT_PK(Al1, Ah1), o[0]); A5_FMA8(p1, 8); A5_DMAP(5); SBAR();
        A5_VRD4(A, 2, 0); A5_W(4); o[1] = A5_MFMA(pa0, ATT_PK(Bl0, Bh0), o[1]); A5_MAXALL(p1); A5_DMAP(6); SBAR();           o[1] = A5_MFMA(pa1, ATT_PK(Bl1, Bh1), o[1]); A5_DECIDE(p1); A5_PIN(p1); A5_DMAP(7); SBAR();
        A5_VRD4(B, 3, 0); A5_W(4); o[2] = A5_MFMA(pa0, ATT_PK(Al0, Ah0), o[2]); A5_EXP2(p1, 0); A5_PIN(p1); SBAR();           o[2] = A5_MFMA(pa1, ATT_PK(Al1, Ah1), o[2]); A5_EXP2(p1, 1); A5_PIN(p1); SBAR();
        A5_VRD4(A, 4, 0); A5_W(4); o[3] = A5_MFMA(pa0, ATT_PK(Bl0, Bh0), o[3]); A5_EXP2(p1, 2); A5_PIN(p1); SBAR();           o[3] = A5_MFMA(pa1, ATT_PK(Bl1, Bh1), o[3]); A5_EXP2(p1, 3); A5_PIN(p1); SBAR();
        A5_VRD4(B, 5, 0); A5_W(4); o[4] = A5_MFMA(pa0, ATT_PK(Al0, Ah0), o[4]); A5_EXP2(p1, 4); A5_PIN(p1); SBAR();           o[4] = A5_MFMA(pa1, ATT_PK(Al1, Ah1), o[4]); A5_EXP2(p1, 5); A5_PIN(p1); SBAR();
        A5_VRD4(A, 6, 0); A5_W(4); o[5] = A5_MFMA(pa0, ATT_PK(Bl0, Bh0), o[5]); A5_EXP2(p1, 6); A5_PIN(p1); SBAR();           o[5] = A5_MFMA(pa1, ATT_PK(Bl1, Bh1), o[5]); A5_EXP2(p1, 7); A5_PIN(p1); SBAR();
        A5_VRD4(B, 7, 0); A5_W(4); o[6] = A5_MFMA(pa0, ATT_PK(Al0, Ah0), o[6]); A5_PK4(p1, 0, pa2); A5_PIN(pa2); SBAR();   o[6] = A5_MFMA(pa1, ATT_PK(Al1, Ah1), o[6]); SBAR();
        A5_VRD4(A, 0, 1); A5_W(4); o[7] = A5_MFMA(pa0, ATT_PK(Bl0, Bh0), o[7]); A5_PK4(p1, 8, pa3); A5_PIN(pa3); SBAR();   o[7] = A5_MFMA(pa1, ATT_PK(Bl1, Bh1), o[7]); SBAR();
        A5_RESC();
        A5_VRD4(B, 1, 1); A5_W(4); o[0] = A5_MFMA(pa2, ATT_PK(Al0, Ah0), o[0]); o[0] = A5_MFMA(pa3, ATT_PK(Al1, Ah1), o[0]); A5_SUM(p1, 0); A5_PIN(l_reg); SBAR();
        A5_VRD4(A, 2, 1); A5_W(4); o[1] = A5_MFMA(pa2, ATT_PK(Bl0, Bh0), o[1]); o[1] = A5_MFMA(pa3, ATT_PK(Bl1, Bh1), o[1]); A5_SUM(p1, 1); A5_PIN(l_reg); SBAR();
        A5_VRD4(B, 3, 1); A5_W(4); o[2] = A5_MFMA(pa2, ATT_PK(Al0, Ah0), o[2]); o[2] = A5_MFMA(pa3, ATT_PK(Al1, Ah1), o[2]); A5_SUM(p1, 2); A5_PIN(l_reg); SBAR();
        A5_VRD4(A, 4, 1); A5_W(4); o[3] = A5_MFMA(pa2, ATT_PK(Bl0, Bh0), o[3]); o[3] = A5_MFMA(pa3, ATT_PK(Bl1, Bh1), o[3]); A5_SUM(p1, 3); A5_PIN(l_reg); SBAR();
        A5_VRD4(B, 5, 1); A5_W(4); o[4] = A5_MFMA(pa2, ATT_PK(Al0, Ah0), o[4]); o[4] = A5_MFMA(pa3, ATT_PK(Al1, Ah1), o[4]); SBAR();
        A5_VRD4(A, 6, 1); A5_W(4); o[5] = A5_MFMA(pa2, ATT_PK(Bl0, Bh0), o[5]); o[5] = A5_MFMA(pa3, ATT_PK(Bl1, Bh1), o[5]); SBAR();
        A5_VRD4(B, 7, 1); A5_W(4); o[6] = A5_MFMA(pa2, ATT_PK(Al0, Ah0), o[6]); o[6] = A5_MFMA(pa3, ATT_PK(Al1, Ah1), o[6]); SBAR();
                          A5_W(0); o[7] = A5_MFMA(pa2, ATT_PK(Bl0, Bh0), o[7]); o[7] = A5_MFMA(pa3, ATT_PK(Bl1, Bh1), o[7]); SBAR();
      }
    }
  }
  asm volatile("s_waitcnt vmcnt(0) lgkmcnt(0)" ::: "memory"); __builtin_amdgcn_s_barrier(); asm volatile("" ::: "memory");
  u32x4 gga[8];
  if (live) { int cb0 = lane + 512 * m; asm volatile("" : "+v"(cb0)); const int rmax = nvalid - 1 - rw * 32;
#pragma unroll
    for (int k = 0; k < 8; ++k) { const int c = cb0 + 64 * k, row = (c >> 5) < rmax ? (c >> 5) : rmax, col = 8 * (c & 31);
      gga[k] = *(const u32x4*)(Gp + (size_t)(rw * 32 + row) * 8192 + col); } }
  float rli[16];
  if (live) {
    { auto rr = __builtin_amdgcn_permlane32_swap(__float_as_uint(l_reg), __float_as_uint(l_reg), false, false); l_reg = __uint_as_float(rr[0]) + __uint_as_float(rr[1]); }
    { constexpr float C = att::SCALE * 1.4426950408889634f; l_reg -= (float)npad * __builtin_amdgcn_exp2f(nmC); }
    if (hi == 0) li_l[r32] = l_reg; asm volatile("s_waitcnt lgkmcnt(0)" ::: "memory");
#pragma unroll
    for (int r = 0; r < 16; ++r) rli[r] = __builtin_amdgcn_rcpf(li_l[crow(r, hi)]);
  }
  LAS float* Xb = (LAS float*)(lds + rw * 32768);
  LAS float* X = Xb + lane;
  if (live && m == 1) {
#pragma unroll
    for (int d = 0; d < 8; ++d)
#pragma unroll
      for (int r = 0; r < 16; ++r) X[(16 * d + r) * 64] = o[d][r] * rli[r];
  }
  asm volatile("s_waitcnt lgkmcnt(0)" ::: "memory"); __builtin_amdgcn_s_barrier(); asm volatile("" ::: "memory");
  if (live && m == 0) {
    float ss[16];
#pragma unroll
    for (int r = 0; r < 16; ++r) ss[r] = 0.f;
#pragma unroll
    for (int d = 0; d < 8; ++d)
#pragma unroll
      for (int r = 0; r < 16; ++r) { const float v = o[d][r] * rli[r] - lam * X[(16 * d + r) * 64]; o[d][r] = v; ss[r] += v * v; }
    int lx = lane << 2; asm volatile("" : "+v"(lx));
#define SHX(v, k) __builtin_bit_cast(float, __builtin_amdgcn_ds_bpermute(lx ^ ((k) << 2), __builtin_bit_cast(int, v)))
#pragma unroll
    for (int r = 0; r < 16; ++r) { float s = ss[r]; s += SHX(s, 1); s += SHX(s, 2); s += SHX(s, 4); s += SHX(s, 8); s += SHX(s, 16);
      ss[r] = (1.0f - LAMBDA_INIT) / sqrtf(s * (1.0f / 256.0f) + 1e-5f); }
#undef SHX
#pragma unroll
    for (int d = 0; d < 8; ++d) { const float sld = subln[d * 32 + r32];
#pragma unroll
      for (int r = 0; r < 16; ++r) Xb[crow(r, hi) * 256 + d * 32 + r32] = o[d][r] * ss[r] * sld; }
  }
  asm volatile("s_waitcnt lgkmcnt(0)" ::: "memory"); __builtin_amdgcn_s_barrier(); asm volatile("" ::: "memory");
  if (live) {
    int cb = lane + 512 * m; asm volatile("" : "+v"(cb));
#pragma unroll
    for (int k = 0; k < 8; ++k) { const int c = cb + 64 * k, row = c >> 5, col = 8 * (c & 31);
      if (rw * 32 + row < nvalid) {
        const f32x4 y0 = *(const LAS f32x4*)(Xb + row * 256 + col), y1 = *(const LAS f32x4*)(Xb + row * 256 + col + 4);
        const size_t go = (size_t)(rw * 32 + row) * 8192 + col;
        const u32x4 gg = gga[k];
        u32x4 w; w.x = pkbf(y0[0] * silu_f(bflo(gg.x)), y0[1] * silu_f(bfhi(gg.x))); w.y = pkbf(y0[2] * silu_f(bflo(gg.y)), y0[3] * silu_f(bfhi(gg.y)));
        w.z = pkbf(y1[0] * silu_f(bflo(gg.z)), y1[1] * silu_f(bfhi(gg.z))); w.w = pkbf(y1[2] * silu_f(bflo(gg.w)), y1[3] * silu_f(bfhi(gg.w)));
        *(u32x4*)(Op + go) = w; } }
  }
  asm volatile("s_waitcnt lgkmcnt(0)" ::: "memory"); __builtin_amdgcn_s_barrier(); asm volatile("" ::: "memory");
#undef ATT2_DMA
}
#undef A5_MFMA
#undef A5_DMA_SETUP
#undef A5_DMAP
#undef A5_PIN
#undef A5_KRD
#undef A5_W
#undef A5_KO
#undef A5_VO
#undef A5_VRD4
#undef A5_MX3
#undef A5_MAXALL
#undef A5_FMA8
#undef A5_DECIDE
#undef A5_RESC
#undef A5_EXP2
#undef A5_SUM
#undef A5_PK4
#undef ATT_TR8
#undef ATT_PK
#undef ATT_MM4
#undef ATT_W8
}

__device__ __forceinline__ unsigned img_off(unsigned row, unsigned ch) { return 2048u * (row >> 3) + 512u * (ch >> 2) + 64u * (row & 7) + 16u * ((ch & 3) ^ ((row >> 2) & 3)); }
__device__ __forceinline__ unsigned img_row_read(unsigned lane, unsigned s) { return img_off(lane & 31, 2 * s + (lane >> 5)); }
__device__ __forceinline__ unsigned img_tr_read(unsigned lane, unsigned c, unsigned ks, unsigned t) {
    const unsigned h = lane >> 5, blk = (lane >> 4) & 1, q = (lane & 15) >> 2, p = lane & 3;
    return img_off(16 * ks + 8 * h + 4 * t + q, 4 * c + 2 * blk + (p >> 1)) + 8 * (p & 1);
}
__device__ __forceinline__ unsigned img_row_read16(unsigned lane, unsigned rb, unsigned s) { return img_off((lane & 15) + 16 * rb, 4 * s + (lane >> 4)); }
__device__ __forceinline__ s16x4 ds_tr(unsigned addr) { s16x4 r; asm volatile("ds_read_b64_tr_b16 %0, %1" : "=&v"(r) : "v"(addr) : "memory"); return r; }
#define CAT8(L, H) (bf16x8){L[0], L[1], L[2], L[3], H[0], H[1], H[2], H[3]}

namespace ret {
constexpr int C = 64;
constexpr int QOFF = 0, KOFF = 32768, VOFF = 65536, VDOFF = 81920, POFF = 98304, OOFF = 114688;
static_assert(OOFF + 16384 <= RING_BYTES, "retention LDS");
constexpr int XOFF = MISC_OFF + 4096;
static_assert(XOFF + 16384 <= LDS_BYTES, "retention exchange");
__device__ __forceinline__ int crow(int r, int hi) { return (r & 3) + 8 * (r >> 2) + 4 * hi; }

__device__ __forceinline__ void chain(Frame& F, const Grp& g, int cid, const bf16_t* Q0, const bf16_t* K0, const bf16_t* V0,
                                      bf16_t* OF, bf16_t* OB, const float* dfw, const float* dbw) {
    const int es = cid & 3, dir = (cid >> 2) & 1, hh = (cid >> 3) & 15, b = cid >> 7;
    const int L = g.L; const size_t rowbase = (size_t)b * g.LP;
    const float lg2 = -__builtin_amdgcn_exp2f((dir ? dbw : dfw)[hh] * 1.4426950408889634f) * 1.4426950408889634f;
    const bf16_t* Qg = Q0 + hh * 256; const bf16_t* Kg = K0 + hh * 256; const bf16_t* Vg = V0 + hh * 512 + es * 128;
    bf16_t* Og = (dir ? OB : OF) + hh * 512 + es * 128;
    const int NC = (L + C - 1) / C;
    const int tid = F.tid, lane = F.lane, wid = F.wave, eb = wid & 3, ih = wid >> 2, h = lane >> 5, l31 = lane & 31;
    LAS unsigned char* lds = F.lds;
    const unsigned ldsb = 0u;
    f32x16 S[4];
#pragma unroll
    for (int i = 0; i < 4; ++i) S[i] = f32x16{};
    u32x4 pq[4], pk[4], pv[2];
    const float gC = __builtin_amdgcn_exp2f(lg2 * (float)C);
#define RET_LOAD(c) do { int tid_ = tid; asm volatile("" : "+v"(tid_)); _Pragma("unroll") for (int i = 0; i < 4; ++i) { const int p = tid_ + 512 * i, r = p >> 5, ch = p & 31; const int f = (c) * C + r; \
            const int pos = f < L ? (dir ? L - 1 - f : f) : L; const size_t go = (rowbase + pos) * 4096 + ch * 8; pq[i] = *(const u32x4*)(Qg + go); pk[i] = *(const u32x4*)(Kg + go); } \
        _Pragma("unroll") for (int i = 0; i < 2; ++i) { const int p = tid_ + 512 * i, r = p >> 4, ch = p & 15; const int f = (c) * C + r; \
            const int pos = f < L ? (dir ? L - 1 - f : f) : L; pv[i] = *(const u32x4*)(Vg + (rowbase + pos) * 8192 + ch * 8); } } while (0)
#define RET_WRITE() do { int tid_ = tid; asm volatile("" : "+v"(tid_)); _Pragma("unroll") for (int i = 0; i < 4; ++i) { const int p = tid_ + 512 * i, r = p >> 5, ch = p & 31; const unsigned o = ((r >> 5) * 2 + (ch >> 4)) * 8192 + img_off(r & 31, ch & 15); \
            *(LAS u32x4*)(lds + QOFF + o) = pq[i]; *(LAS u32x4*)(lds + KOFF + o) = pk[i]; } \
        _Pragma("unroll") for (int i = 0; i < 2; ++i) { const int p = tid_ + 512 * i, r = p >> 4, ch = p & 15; const unsigned o = (r >> 5) * 8192 + img_off(r & 31, ch); \
            *(LAS u32x4*)(lds + VOFF + o) = pv[i]; const float kd = __builtin_amdgcn_exp2f(lg2 * (float)(C - 1 - r)); u32x4 w; \
            _Pragma("unroll") for (int q = 0; q < 4; ++q) w[q] = pkbf(bflo(pv[i][q]) * kd, bfhi(pv[i][q]) * kd); \
            *(LAS u32x4*)(lds + VDOFF + o) = w; } } while (0)
    const unsigned l15 = lane & 15, g4 = lane >> 4, x2 = (l31 >> 2) & 3;
    const unsigned lp32 = 2048u * (l31 >> 3) + 64u * (l31 & 7);
    const unsigned rr16 = 2048u * (l15 >> 3) + 64u * (l15 & 7) + 16u * (g4 ^ ((l15 >> 2) & 3));
    const int it = wid & 3, jt0 = 2 * (wid >> 2);
    const unsigned kb16_0 = KOFF + (jt0 >> 1) * 16384 + rr16, kb16_1 = kb16_0 + 4096;
    const unsigned qb16 = QOFF + (it >> 1) * 16384 + (it & 1) * 4096 + rr16;
    const unsigned qxb = QOFF + (1 - ih) * 16384 + ih * 8192 + lp32 + 8u * h;
    const unsigned qx0 = qxb + 16u * (0u ^ x2), qx1 = qxb + 16u * (1u ^ x2), qx2 = qxb + 16u * (2u ^ x2), qx3 = qxb + 16u * (3u ^ x2);
    const unsigned xw = XOFF + (unsigned)wid * 2048u + (unsigned)lane * 16u, xr = XOFF + (unsigned)(wid ^ 4) * 2048u + (unsigned)lane * 16u;
    const unsigned pr_e = POFF + ih * 8192 + lp32 + 16u * ((0u + h) ^ x2), pr_o = POFF + ih * 8192 + lp32 + 16u * ((2u + h) ^ x2);
    const unsigned q4 = (lane & 15) >> 2, p3 = lane & 3, xx = 2u * ((lane >> 4) & 1) + (p3 >> 1);
    const unsigned tr0 = 2048u * h + 64u * q4 + 16u * (xx ^ (2u * h)) + 8u * (p3 & 1), tr1 = 2048u * h + 64u * q4 + 256u + 16u * (xx ^ (2u * h + 1u)) + 8u * (p3 & 1);
    const unsigned vtr0 = ldsb + VOFF + 512u * eb + tr0, vtr1 = ldsb + VOFF + 512u * eb + tr1;
    const unsigned vdtr0 = ldsb + VDOFF + 512u * eb + tr0, vdtr1 = ldsb + VDOFF + 512u * eb + tr1;
    const unsigned ktr0 = ldsb + KOFF + ih * 8192 + tr0, ktr1 = ldsb + KOFF + ih * 8192 + tr1;
    const int pi = 16 * it + (int)l15;
    const unsigned pw0 = POFF + (pi >> 5) * 8192 + img_off(pi & 31, (16 * jt0 + 4 * g4) >> 3) + ((4 * g4) & 7) * 2,
                   pw1 = POFF + (pi >> 5) * 8192 + img_off(pi & 31, (16 * (jt0 + 1) + 4 * g4) >> 3) + ((4 * g4) & 7) * 2;
#define TR(base, OFF) ({ s16x4 r_; asm volatile("ds_read_b64_tr_b16 %0, %1 offset:%2" : "=&v"(r_) : "v"(base), "i"(OFF) : "memory"); r_; })
    RET_LOAD(0);
    RET_WRITE();
    __syncthreads();
#pragma unroll 1
    for (int c = 0; c < NC; ++c) {
#define RD128(dst, base, OFF) asm volatile("ds_read_b128 %0, %1 offset:%2" : "=&v"(dst) : "v"(base), "i"(OFF) : "memory")
#define RD64(dst, base, OFF) asm volatile("ds_read_b64 %0, %1 offset:%2" : "=&v"(dst) : "v"(base), "i"(OFF) : "memory")
#define LW(n) do { asm volatile("s_waitcnt lgkmcnt(" #n ")" ::: "memory"); __builtin_amdgcn_sched_barrier(0); } while (0)
#define KSO(ks) (((ks) >> 2) * 8192 + ((ks) & 3) * 512)
        {
            f32x4 sacc0 = (f32x4){0.f, 0.f, 0.f, 0.f}, sacc1 = sacc0;
            bf16x8 xa0, xa1, xq, ya0, ya1, yq;
            LW(0);
#define SC_RD(P, ks) do { RD128(P##a0, kb16_0, KSO(ks)); RD128(P##a1, kb16_1, KSO(ks)); RD128(P##q, qb16, KSO(ks)); } while (0)
#define SC_MM(P) do { sacc0 = __builtin_amdgcn_mfma_f32_16x16x32_bf16(P##a0, P##q, sacc0, 0, 0, 0); sacc1 = __builtin_amdgcn_mfma_f32_16x16x32_bf16(P##a1, P##q, sacc1, 0, 0, 0); __builtin_amdgcn_sched_barrier(0); } while (0)
            SC_RD(x, 0); SC_RD(y, 1);
            LW(3); SC_MM(x); SC_RD(x, 2);
            LW(3); SC_MM(y); SC_RD(y, 3);
            LW(3); SC_MM(x); SC_RD(x, 4);
            LW(3); SC_MM(y); SC_RD(y, 5);
            LW(3); SC_MM(x); SC_RD(x, 6);
            LW(3); SC_MM(y); SC_RD(y, 7);
            LW(3); SC_MM(x);
            LW(0); SC_MM(y);
#undef SC_RD
#undef SC_MM
#pragma unroll
            for (int tt = 0; tt < 2; ++tt) {
                int dl0 = pi - (16 * (jt0 + tt) + 4 * (int)g4); asm volatile("" : "+v"(dl0));
                float p[4];
#pragma unroll
                for (int r = 0; r < 4; ++r) { const int dl = dl0 - r; const bool on = dl > 0 || (dl == 0 && dir == 0);
                    p[r] = on ? (tt ? sacc1[r] : sacc0[r]) * __builtin_amdgcn_exp2f(lg2 * (float)dl) : 0.f; }
                *(LAS u32x2*)(lds + (tt ? pw1 : pw0)) = (u32x2){pkbf(p[0], p[1]), pkbf(p[2], p[3])};
            }
        }
        f32x16 O = f32x16{};
        {
            u32x4 bw[4][2];
#pragma unroll
            for (int db = 0; db < 4; ++db)
#pragma unroll
                for (int s = 0; s < 2; ++s) { bw[db][s].x = pkbf(S[db][8 * s + 0], S[db][8 * s + 1]); bw[db][s].y = pkbf(S[db][8 * s + 2], S[db][8 * s + 3]); bw[db][s].z = pkbf(S[db][8 * s + 4], S[db][8 * s + 5]); bw[db][s].w = pkbf(S[db][8 * s + 6], S[db][8 * s + 7]); }
#define CR_RD(b0, b1, b2, b3, db) do { RD64(ql[2 * (db)], b0, (db) * 512); RD64(qh[2 * (db)], b1, (db) * 512); RD64(ql[2 * (db) + 1], b2, (db) * 512); RD64(qh[2 * (db) + 1], b3, (db) * 512); } while (0)
#define CR_MM(ACC, db) do { _Pragma("unroll") for (int s = 0; s < 2; ++s) { \
                    const u32x4 aw = (u32x4){ql[2 * (db) + s].x, ql[2 * (db) + s].y, qh[2 * (db) + s].x, qh[2 * (db) + s].y}; \
                    ACC = __builtin_amdgcn_mfma_f32_32x32x16_bf16(__builtin_bit_cast(bf16x8, aw), __builtin_bit_cast(bf16x8, bw[db][s]), ACC, 0, 0, 0); } } while (0)
            u32x2 ql[8], qh[8];
            f32x16 Op = f32x16{};
            CR_RD(qx0, qx1, qx2, qx3, 0); CR_RD(qx0, qx1, qx2, qx3, 1); CR_RD(qx0, qx1, qx2, qx3, 2); CR_RD(qx0, qx1, qx2, qx3, 3); LW(0);
            CR_MM(Op, 0); CR_MM(Op, 1); CR_MM(Op, 2); CR_MM(Op, 3); __builtin_amdgcn_sched_barrier(0);
            { const unsigned o0 = qx0 ^ 16384u, o1 = qx1 ^ 16384u, o2 = qx2 ^ 16384u, o3 = qx3 ^ 16384u;
              CR_RD(o0, o1, o2, o3, 0); CR_RD(o0, o1, o2, o3, 1); CR_RD(o0, o1, o2, o3, 2); CR_RD(o0, o1, o2, o3, 3); }
            { u32x4 w0, w1; w0.x = pkbf(Op[0], Op[1]); w0.y = pkbf(Op[2], Op[3]); w0.z = pkbf(Op[4], Op[5]); w0.w = pkbf(Op[6], Op[7]);
              w1.x = pkbf(Op[8], Op[9]); w1.y = pkbf(Op[10], Op[11]); w1.z = pkbf(Op[12], Op[13]); w1.w = pkbf(Op[14], Op[15]);
              LW(0);
              *(LAS u32x4*)(lds + xw) = w0; *(LAS u32x4*)(lds + xw + 1024) = w1; }
            CR_MM(O, 0); CR_MM(O, 1); CR_MM(O, 2); CR_MM(O, 3);
#undef CR_RD
#undef CR_MM
        }
#undef RD128
#undef RD64
#undef LW
#undef KSO
        __syncthreads();
        { const u32x4 w0 = *(const LAS u32x4*)(lds + xr), w1 = *(const LAS u32x4*)(lds + xr + 1024);
          O[0] += bflo(w0.x); O[1] += bfhi(w0.x); O[2] += bflo(w0.y); O[3] += bfhi(w0.y); O[4] += bflo(w0.z); O[5] += bfhi(w0.z); O[6] += bflo(w0.w); O[7] += bfhi(w0.w);
          O[8] += bflo(w1.x); O[9] += bfhi(w1.x); O[10] += bflo(w1.y); O[11] += bfhi(w1.y); O[12] += bflo(w1.z); O[13] += bfhi(w1.z); O[14] += bflo(w1.w); O[15] += bfhi(w1.w); }
        { int rb_ = 32 * ih + 4 * h + 1; asm volatile("" : "+v"(rb_));
#pragma unroll
          for (int r = 0; r < 16; ++r) O[r] *= __builtin_amdgcn_exp2f(lg2 * (float)(rb_ + (r & 3) + 8 * (r >> 2))); }
        {
            bf16x8 pa[4]; s16x4 vl[4], vh[4];
#pragma unroll
            for (int ks = 0; ks < 4; ++ks) pa[ks] = *(const LAS bf16x8*)(lds + ((ks & 1) ? pr_o : pr_e) + (ks >> 1) * 512);
            vl[0] = TR(vtr0, 0); vh[0] = TR(vtr1, 0); vl[1] = TR(vtr0, 4096); vh[1] = TR(vtr1, 4096);
            vl[2] = TR(vtr0, 8192); vh[2] = TR(vtr1, 8192); vl[3] = TR(vtr0, 12288); vh[3] = TR(vtr1, 12288);
            asm volatile("s_waitcnt lgkmcnt(0)" ::: "memory"); __builtin_amdgcn_sched_barrier(0);
#pragma unroll
            for (int ks = 0; ks < 4; ++ks) O = __builtin_amdgcn_mfma_f32_32x32x16_bf16(pa[ks], CAT8(vl[ks], vh[ks]), O, 0, 0, 0);
        }
        { int ob = OOFF + (32 * ih + 4 * h) * 256 + (32 * eb + l31) * 2; asm volatile("" : "+v"(ob));
#pragma unroll
          for (int r = 0; r < 16; ++r) *(LAS bf16_t*)(lds + ob + ((r & 3) + 8 * (r >> 2)) * 256) = (bf16_t)(pkbf(O[r], 0.f) & 0xffffu); }
        if (c + 1 < NC) RET_LOAD(c + 1);
#pragma unroll
        for (int db = 0; db < 4; ++db)
#pragma unroll
            for (int r = 0; r < 16; ++r) S[db][r] *= gC;
#define LWU(n) do { asm volatile("s_waitcnt lgkmcnt(" #n ")" ::: "memory"); __builtin_amdgcn_sched_barrier(0); } while (0)
#define UP_O(ks, dh, dq) ((((ks) >> 1) * 2) * 8192 + ((ks) & 1) * 4096 + (dq) * 512)
#define UP_RD(P, ks, dh) do { P##0l = TR(ktr0, UP_O(ks, dh, 0)); P##0h = TR(ktr1, UP_O(ks, dh, 0)); P##1l = TR(ktr0, UP_O(ks, dh, 1)); P##1h = TR(ktr1, UP_O(ks, dh, 1)); \
                              P##2l = TR(ktr0, UP_O(ks, dh, 2)); P##2h = TR(ktr1, UP_O(ks, dh, 2)); P##3l = TR(ktr0, UP_O(ks, dh, 3)); P##3h = TR(ktr1, UP_O(ks, dh, 3)); } while (0)
#define UP_RDB(Q, ks) do { Q##l = TR(vdtr0, ((ks) >> 1) * 8192 + ((ks) & 1) * 4096); Q##h = TR(vdtr1, ((ks) >> 1) * 8192 + ((ks) & 1) * 4096); } while (0)
#define UP_MM(P, Q, dh) do { S[4 * (dh) + 0] = __builtin_amdgcn_mfma_f32_32x32x16_bf16(CAT8(P##0l, P##0h), CAT8(Q##l, Q##h), S[4 * (dh) + 0], 0, 0, 0); \
                             S[4 * (dh) + 1] = __builtin_amdgcn_mfma_f32_32x32x16_bf16(CAT8(P##1l, P##1h), CAT8(Q##l, Q##h), S[4 * (dh) + 1], 0, 0, 0); \
                             S[4 * (dh) + 2] = __builtin_amdgcn_mfma_f32_32x32x16_bf16(CAT8(P##2l, P##2h), CAT8(Q##l, Q##h), S[4 * (dh) + 2], 0, 0, 0); \
                             S[4 * (dh) + 3] = __builtin_amdgcn_mfma_f32_32x32x16_bf16(CAT8(P##3l, P##3h), CAT8(Q##l, Q##h), S[4 * (dh) + 3], 0, 0, 0); __builtin_amdgcn_sched_barrier(0); } while (0)
        {
            s16x4 aA0l, aA0h, aA1l, aA1h, aA2l, aA2h, aA3l, aA3h, aB0l, aB0h, aB1l, aB1h, aB2l, aB2h, aB3l, aB3h, bAl, bAh, bBl, bBh;
            LWU(0);
            UP_RDB(bA, 0); UP_RD(aA, 0, 0);
            UP_RDB(bB, 1); UP_RD(aB, 1, 0);  LWU(10); UP_MM(aA, bA, 0);
            UP_RDB(bA, 2); UP_RD(aA, 2, 0);  LWU(10); UP_MM(aB, bB, 0);
            UP_RDB(bB, 3); UP_RD(aB, 3, 0);  LWU(10); UP_MM(aA, bA, 0);
                                             LWU(0);  UP_MM(aB, bB, 0);
        }
#undef LWU
#undef UP_O
#undef UP_RD
#undef UP_RDB
#undef UP_MM
        __syncthreads();
        { int t2 = tid; asm volatile("" : "+v"(t2));
#pragma unroll
          for (int i = 0; i < 2; ++i) { const int idx = t2 + 512 * i, row = idx >> 4, ch = idx & 15; const int f = c * C + row;
            if (f < L) { const int pos = dir ? L - 1 - f : f; *(u32x4*)(Og + (rowbase + pos) * 8192 + ch * 8) = *(const LAS u32x4*)(lds + OOFF + row * 256 + ch * 16); } } }
        if (c + 1 < NC) { RET_WRITE(); }
        __syncthreads();
    }
#undef TR
#undef RET_LOAD
#undef RET_WRITE
}
__device__ __forceinline__ void phase(Frame& F, const Grp& g, const bf16_t* Q0, const bf16_t* K0, const bf16_t* V0, bf16_t* OF, bf16_t* OB, const float* dfw, const float* dbw) {
    const int nx = (F.G & 7) ? 1 : 8;
    const int xcd = blockIdx.x % nx, slot = blockIdx.x / nx, nslot = F.G / nx, nlx = g.nseq * 128 / nx;
    for (int li = slot; li < nlx; li += nslot) { const int cid = ((li >> 3) * nx + xcd) * 8 + (li & 7); chain(F, g, cid, Q0, K0, V0, OF, OB, dfw, dbw); }
}
}
#ifndef ATT_NS
#define ATT_NS att5
#endif
#ifndef SPLITK
#define SPLITK 1
#endif

__device__ __forceinline__ void phase_reduce_tail(Frame& F, const Grp& g, bf16_t* Mbuf, const float* P) {
    pg8::StaticOrder S; S.init(g.TP, DM, 8192, F.G, (int)blockIdx.x, 1);
    const int nt = S.n_tail(); if (nt == 0 || (int)blockIdx.x >= nt * S.S) return;
    const int lu = (int)blockIdx.x / S.S, ks = (int)blockIdx.x - lu * S.S, rows = 256 / S.S;
    pg8::Unit u; S.tail_tile(lu, u);
    for (int i = F.tid; i < rows * 32; i += 512) { const int r = ks * rows + (i >> 5), c8 = (i & 31) * 8;
        const float* src = P + (size_t)(lu * S.S) * 65536 + r * 256 + c8; f32x4 a = (f32x4){0.f, 0.f, 0.f, 0.f}, b = a;
        for (int s = 0; s < S.S; ++s) { a += *(const f32x4*)(src + (size_t)s * 65536); b += *(const f32x4*)(src + (size_t)s * 65536 + 4); }
        u32x4 w; w.x = pkbf(a[0], a[1]); w.y = pkbf(a[2], a[3]); w.z = pkbf(b[0], b[1]); w.w = pkbf(b[2], b[3]);
        *(u32x4*)(Mbuf + (size_t)(u.pm * 256 + r) * DM + u.pn * 256 + c8) = w; }
}

template <int VARIANT>
__device__ __forceinline__ void phase_attn2(Frame& F, const Grp& g, const bf16_t* R0, const bf16_t* R1, const bf16_t* R2, const bf16_t* R3, bf16_t* R4,
                                            const float* lq1, const float* lk1, const float* lq2, const float* lk2, const float* subln) {
    float lam;
    { const float a = lq1[F.lane] * lk1[F.lane] + lq1[F.lane + 64] * lk1[F.lane + 64], c = lq2[F.lane] * lk2[F.lane] + lq2[F.lane + 64] * lk2[F.lane + 64];
      lam = __builtin_amdgcn_exp2f(wave_sum(a) * 1.4426950408889634f) - __builtin_amdgcn_exp2f(wave_sum(c) * 1.4426950408889634f) + LAMBDA_INIT; }
    const int NQF = g.L / 128, tail = (g.L % 128) != 0, nfull = g.nseq * 32 * NQF, nu = nfull + (tail ? g.nseq * 32 : 0);
    const int nt = (g.L + 63) / 64;
    const int npad = __builtin_amdgcn_readfirstlane(nt * 64 - g.L);
    const int nx = (F.G & 7) ? 1 : 8;
    const int xcd = blockIdx.x % nx, slot = blockIdx.x / nx, nslot = F.G / nx, npair8 = g.nseq * 32 / nx;
    const int nfx = npair8 * NQF, nux = nfx + (tail ? npair8 : 0);
    (void)nu; (void)nfull;
    for (int li = slot; li < nux; li += nslot) {
        const int qb = li < nfx ? li % NQF : NQF, t = (li < nfx ? li / NQF : li - nfx) * nx + xcd, hh = t & 31, b = t >> 5;
        const size_t seqrow = (size_t)b * g.LP, qoff = (seqrow + (size_t)qb * 128) * 8192 + (size_t)hh * 256, koff = seqrow * 8192 + (size_t)hh * 256;
        const int nvalid = (g.L - qb * 128) < 128 ? (g.L - qb * 128) : 128;
        ATT_NS::unit<VARIANT>(R0 + qoff, R4 + qoff, R3 + qoff, R1 + koff, R2 + koff, nt, nvalid, npad, lam, subln, F.lds, F.ldsg, F.tid);
    }
}

#ifndef REP_G1
#define REP_G1 1
#endif
#ifndef REP_G2
#define REP_G2 1
#endif
#ifndef REP_RET
#define REP_RET 1
#endif
#ifndef REP_ATT
#define REP_ATT 1
#endif
#ifndef G1_PROBE
#define G1_PROBE 0
#endif
#ifndef REP_W
#define REP_W 1
#endif

#ifndef ATT_PROBE
#define ATT_PROBE 0
#endif
constexpr int NPHASES = 20 + 4 * SPLITK + 4 * (REP_G1 - 1) + 4 * (REP_G2 - 1) + 2 * (REP_RET - 1) + 2 * (REP_ATT - 1) + 2 * (ATT_PROBE != 0) + 4 * G1_PROBE + 2 * (REP_W - 1);
struct Args { const float* in[16]; float* out; unsigned char* ws; int ph_lo, ph_hi, li, pad; };
__global__ void __launch_bounds__(512, 2) mk_fwd(Args args) {
    extern __shared__ __attribute__((aligned(16))) unsigned char lds_raw[];
    Frame F;
    F.lds = (LAS unsigned char*)lds_raw; F.ldsg = (char*)lds_raw;
    const int wave0 = __builtin_amdgcn_readfirstlane((int)threadIdx.x >> 6);
    F.wave = wave0; F.lane = lane_id_now(); F.tid = wave0 * 64 + F.lane;
    F.G = gridDim.x; F.gw = blockIdx.x * 8 + F.wave; F.ngw = F.G * 8;
    F.ws = args.ws;
    volatile LAS unsigned* MISC = (volatile LAS unsigned*)(F.lds + MISC_OFF);
    if (F.tid < 16) MISC[F.tid] = 0u;
    __syncthreads();
    unsigned* ctl = (unsigned*)(F.ws + WS_CTL);
    XcdBarrier bar = xcd_barrier_post(ctl + CW_BAR + args.li * XCD_BAR_WORDS, MISC + 8, wave0);
    xcd_barrier(bar);
    const int lo = args.ph_lo, hi = args.ph_hi;
    int ph = 0;
#define RUN(...) do { if (ph >= lo && ph < hi) { __builtin_amdgcn_s_waitcnt(0);   { int t_ = wave0 * 64 + lane_id_now(); asm volatile("" : "+v"(t_)); F.tid = t_; F.lane = t_ & 63; F.wave = wave0; F.gw = blockIdx.x * 8 + F.wave; } \
        __VA_ARGS__; if (ph + 1 < hi) xcd_barrier_nc(bar); } ++ph; } while (0)

    bf16_t* const H = (bf16_t*)(F.ws + WS_H);
    bf16_t* const R0 = (bf16_t*)(F.ws + WS_R), * const R1 = (bf16_t*)(F.ws + WS_R + RS), * const R2 = (bf16_t*)(F.ws + WS_R + 2 * RS), * const R3 = (bf16_t*)(F.ws + WS_R + 3 * RS), * const R4 = (bf16_t*)(F.ws + WS_R + 4 * RS);
    bf16_t* const WinT = (bf16_t*)(F.ws + WS_W);

#define GRP_A(g) Grp g; g.nseq = NSEQ_A; g.L = L_A; g.LP = LP_A; g.TP = TP_A; g.seq0 = 0; g.x = args.in[0]; g.y = args.out
#define GRP_B(g) Grp g; g.nseq = NSEQ_B; g.L = L_B; g.LP = LP_B; g.TP = TP_B; g.seq0 = NSEQ_A; g.x = args.in[1]; g.y = args.out + (size_t)NSEQ_A * (L_A - NMETA) * DM
    bf16_t* const Q0 = R0; bf16_t* const K0 = R0 + (size_t)TPMAX * 4096;
#define LAYER0(GRP, H1) do { GRP(g); \
        if (G1_PROBE) RUN({ pg8::Gemm gm{H, WinT, g.TP, 24576, DM}; pg8::StaticOrder S; S.init(g.TP, 24576, DM, F.G, (int)blockIdx.x, 0); \
              pg8::EpiProj E{Q0, (size_t)TPMAX * 4096, 4096, 12, 8192, R1, RS / 2, 8192, 13}; pg8::gemm_phase<pg8::EpiProj, pg8::StaticOrder>(F.lds, gm, S, E, F.tid); });     \
        for (int rep = 0; rep < REP_G1; ++rep) \
        RUN({ pg8::Gemm gm{H, WinT, g.TP, 24576, DM}; pg8::StaticOrder S; S.init(g.TP, 24576, DM, F.G, (int)blockIdx.x, 0); \
              pg8::EpiProj E{Q0, (size_t)TPMAX * 4096, 4096, 12, 8192, R1, RS / 2, 8192, 13};     \
              pg8::EpiProjRope<0> ER{E, (const bf16_t*)(F.ws + WS_COSR), (const bf16_t*)(F.ws + WS_SINR), g.LP}; \
              pg8::gemm_phase<pg8::EpiProjRope<0>, pg8::StaticOrder>(F.lds, gm, S, ER, F.tid); }); \
        for (int rep = 0; rep < REP_RET; ++rep) \
        RUN(ret::phase(F, g, Q0, K0, R1, R3, R4, args.in[7], args.in[8])); \
        RUN(phase_gate0(F, g, R3, R4, R2)); \
        for (int rep = 0; rep < REP_G2; ++rep) \
        RUN({ pg8::Gemm gm{R3, WinT + (size_t)24576 * DM, g.TP, DM, 8192}; pg8::StaticOrder S; S.init(g.TP, DM, 8192, F.G, (int)blockIdx.x, SPLITK); \
              pg8::EpiM E{R0, DM, (float*)H};                                                      \
              pg8::gemm_phase<pg8::EpiM, pg8::StaticOrder>(F.lds, gm, S, E, F.tid); }); \
        if (SPLITK) RUN(phase_reduce_tail(F, g, R0, (const float*)H)); } while (0)
#define LAYER1(GRP, H1) do { GRP(g); \
        if (G1_PROBE) RUN({ pg8::Gemm gm{H1, WinT, g.TP, 32768, DM}; pg8::StaticOrder S; S.init(g.TP, 32768, DM, F.G, (int)blockIdx.x, 0); \
              pg8::EpiProj E{R0, RS / 2, 8192, 13, 0, R0, RS / 2, 8192, 13}; pg8::gemm_phase<pg8::EpiProj, pg8::StaticOrder>(F.lds, gm, S, E, F.tid); }); \
        for (int rep = 0; rep < REP_G1; ++rep) \
        RUN({ pg8::Gemm gm{H1, WinT, g.TP, 32768, DM}; pg8::StaticOrder S; S.init(g.TP, 32768, DM, F.G, (int)blockIdx.x, 0); \
              pg8::EpiProj E{R0, RS / 2, 8192, 13, 0, R0, RS / 2, 8192, 13};                         \
              pg8::EpiProjRope<1> ER{E, (const bf16_t*)(F.ws + WS_COSD), (const bf16_t*)(F.ws + WS_SIND), g.LP}; \
              pg8::gemm_phase<pg8::EpiProjRope<1>, pg8::StaticOrder>(F.lds, gm, S, ER, F.tid); }); \
        if (ATT_PROBE) RUN(phase_attn2<ATT_PROBE>(F, g, R0, R1, R2, R3, R4, args.in[11], args.in[12], args.in[13], args.in[14], args.in[15]));   \
        for (int rep = 0; rep < REP_ATT; ++rep) \
        RUN(phase_attn2<0>(F, g, R0, R1, R2, R3, R4, args.in[11], args.in[12], args.in[13], args.in[14], args.in[15])); \
        for (int rep = 0; rep < REP_G2; ++rep) \
        RUN({ pg8::Gemm gm{R4, WinT + (size_t)32768 * DM, g.TP, DM, 8192}; pg8::StaticOrder S; S.init(g.TP, DM, 8192, F.G, (int)blockIdx.x, SPLITK); \
              pg8::EpiM E{R1, DM, (float*)H1};                                                     \
              pg8::gemm_phase<pg8::EpiM, pg8::StaticOrder>(F.lds, gm, S, E, F.tid); }); \
        if (SPLITK) RUN(phase_reduce_tail(F, g, R1, (const float*)H1)); \
        RUN(phase_post(F, g, 1, R1, args.in[2], args.in[4], H1, args.in[3])); } while (0)
    for (int rep = 0; rep < REP_W; ++rep)
    RUN({ phase_tables(F); phase_weights(F, args.in[5], 24576, args.in[6]); });
    bf16_t* const H2 = (bf16_t*)(F.ws + WS_H2);
    { GRP_A(ga); RUN(phase_norm(F, ga, 0, args.in[2], args.in[3])); }
    LAYER0(GRP_A, H2);
    { GRP_A(ga); GRP_B(gb); RUN({ phase_post(F, ga, 0, R0, args.in[2], args.in[4], H2, args.in[3]); phase_norm(F, gb, 0, args.in[2], args.in[3]); }); }
    LAYER0(GRP_B, H);
    { GRP_B(gb); RUN({ phase_post(F, gb, 0, R0, args.in[2], args.in[4], H, args.in[3]); phase_weights(F, args.in[9], 32768, args.in[10]); }); }
    LAYER1(GRP_A, H2);
    LAYER1(GRP_B, H);
#undef LAYER0
#undef LAYER1
#undef GRP_A
#undef GRP_B
#undef RUN
}

#ifndef MK_CUTS
#define MK_CUTS {0, NPHASES}
#endif
extern "C" void kernel_launch(void* const* d_in, const int* in_sizes, int n_in, void* d_out, int out_size, void* d_ws, size_t ws_size, hipStream_t stream) {
    static int grid = 0;
    if (grid == 0) {
        if (n_in != 16 || ws_size < WS_END) { fprintf(stderr, "kernel_launch: need 16 inputs and >= %zu bytes of workspace; got n_in %d, ws %zu\n", (size_t)WS_END, n_in, ws_size); grid = -1; return; }
        int dev = 0, cus = 0, per_cu = 0;
        if (hipGetDevice(&dev) != hipSuccess || hipDeviceGetAttribute(&cus, hipDeviceAttributeMultiprocessorCount, dev) != hipSuccess) { grid = -1; return; }
        if (hipFuncSetAttribute((const void*)mk_fwd, hipFuncAttributeMaxDynamicSharedMemorySize, LDS_BYTES) != hipSuccess) { fprintf(stderr, "kernel_launch: hipFuncSetAttribute failed\n"); grid = -1; return; }
        if (hipOccupancyMaxActiveBlocksPerMultiprocessor(&per_cu, (const void*)mk_fwd, 512, LDS_BYTES) != hipSuccess || per_cu < 1)
            fprintf(stderr, "kernel_launch: note: occupancy query reports %d workgroups per CU\n", per_cu);
        (void)hipGetLastError();
        grid = cus;
    }
    if (grid < 0) return;
    (void)in_sizes; (void)out_size;
    if (hipMemsetAsync((char*)d_ws + WS_CTL, 0, CTL_ZERO_BYTES, stream) != hipSuccess) { fprintf(stderr, "kernel_launch: memset failed\n"); return; }
    Args a{};
    for (int i = 0; i < 16; ++i) a.in[i] = (const float*)d_in[i];
    a.out = (float*)d_out; a.ws = (unsigned char*)d_ws; a.pad = 0;
    const int cuts[] = MK_CUTS; const int ncut = (int)(sizeof(cuts) / sizeof(cuts[0])) - 1;
    for (int li = 0; li < ncut; ++li) {
        a.ph_lo = cuts[li]; a.ph_hi = cuts[li + 1]; a.li = li;
        hipLaunchKernelGGL(mk_fwd, dim3(grid), dim3(512), LDS_BYTES, stream, a);
        const hipError_t le = hipPeekAtLastError();
        if (le != hipSuccess) { fprintf(stderr, "kernel_launch: launch %d failed: %s\n", li, hipGetErrorName(le)); break; }
    }
}
```
